# Optimizing an MI355X kernel written in HIP

```python
import jax, jax.numpy as jnp
from jax import lax
import numpy as np

D_MODEL = 1024
BATCH = 8
SEQ = 2048
DEPTH = 4

GRID_W = 64
N_HEADS = 8
HEAD_DIM = 64
D_ATTN = N_HEADS * HEAD_DIM
KH_MAX = 8
KW = 16
Q_BLOCK = KW
K_BLOCK = 2 * KW
POOL_WINDOWS = (2, 4, 8, 16)
POOL_GROUPS = len(POOL_WINDOWS)
D_POOL = 512
POOL_GROUP_DIM = D_POOL // POOL_GROUPS
D_FF = 2816
CONV_W = 3
PLE_DIM = 256
N_PROJ = 3 * D_ATTN + D_POOL + 2 * D_MODEL
ALPHA = (2 * DEPTH) ** 0.25
BETA = (8 * DEPTH) ** -0.25
LN_EPS = 1e-5
NEG_INF = -1e30

kernel_name = "hybrid_natten_pool_convffn_encoder"


def layer_norm(x, g, b):
    xf = x.astype(jnp.float32)
    mu = jnp.mean(xf, axis=-1, keepdims=True)
    xc = xf - mu
    var = jnp.mean(xc * xc, axis=-1, keepdims=True)
    y = xc * lax.rsqrt(var + LN_EPS)
    return (y * g.astype(jnp.float32) + b.astype(jnp.float32)).astype(x.dtype)


def neighbourhood_attention(q, k, v, rpb):
    b, s, _ = q.shape
    rows = s // GRID_W
    kh = min(KH_MAX, rows)

    def to_grid(t):
        return t.reshape(b, rows, GRID_W, N_HEADS, HEAD_DIM).transpose(0, 3, 1, 2, 4)

    q, k, v = to_grid(q), to_grid(k), to_grid(v)
    r = np.arange(rows)
    row_start = np.clip(r - kh // 2, 0, rows - kh)
    row_idx = row_start[:, None] + np.arange(kh)
    k_rows = k[:, :, row_idx]
    v_rows = v[:, :, row_idx]
    row_off = row_idx - r[:, None] + KH_MAX - 1
    scale = HEAD_DIM ** -0.5
    outs = []
    for c0q in range(0, GRID_W, Q_BLOCK):
        c0k = int(np.clip(c0q - KW // 2, 0, GRID_W - K_BLOCK))
        qc = c0q + np.arange(Q_BLOCK)
        kc = c0k + np.arange(K_BLOCK)
        col_start = np.clip(qc - KW // 2, 0, GRID_W - KW)
        valid = (kc[None, :] >= col_start[:, None]) & (kc[None, :] < col_start[:, None] + KW)
        col_off = np.clip(kc[None, :] - qc[:, None], -(KW - 1), KW - 1) + KW - 1
        bias = rpb[:, row_off[:, None, :, None], col_off[None, :, None, :]]
        qb = q[:, :, :, c0q:c0q + Q_BLOCK]
        kb = k_rows[:, :, :, :, c0k:c0k + K_BLOCK]
        vb = v_rows[:, :, :, :, c0k:c0k + K_BLOCK]
        sc = jnp.einsum('bhrqd,bhrikd->bhrqik', qb, kb).astype(jnp.float32) * scale + bias.astype(jnp.float32)
        sc = jnp.where(valid[:, None, :], sc, NEG_INF)
        pr = jax.nn.softmax(sc.reshape(b, N_HEADS, rows, Q_BLOCK, kh * K_BLOCK), axis=-1)
        pr = pr.reshape(sc.shape).astype(v.dtype)
        outs.append(jnp.einsum('bhrqik,bhrikd->bhrqd', pr, vb))
    o = jnp.concatenate(outs, axis=3)
    return o.transpose(0, 2, 3, 1, 4).reshape(b, s, D_ATTN)


def multiscale_pool(u):
    b, s, _ = u.shape
    uf = u.astype(jnp.float32)
    cs = jnp.concatenate([jnp.zeros((b, 1, D_POOL), jnp.float32), jnp.cumsum(uf, axis=1)], axis=1)
    t = np.arange(s)
    outs = []
    for g, w in enumerate(POOL_WINDOWS):
        lo = np.clip(t - w // 2, 0, s)
        hi = np.clip(t + w // 2, 0, s)
        cnt = (hi - lo).astype(np.float32)
        sl = slice(g * POOL_GROUP_DIM, (g + 1) * POOL_GROUP_DIM)
        csg = cs[:, :, sl]
        mean = (csg[:, hi] - csg[:, lo]) / cnt[None, :, None]
        outs.append(mean - uf[:, :, sl])
    return jnp.concatenate(outs, axis=-1).astype(u.dtype)


def dwconv_centred(h, w, bias):
    s = h.shape[1]
    pad = CONV_W // 2
    hp = jnp.pad(h, ((0, 0), (pad, CONV_W - 1 - pad), (0, 0)))
    y = hp[:, 0:s] * w[0]
    for j in range(1, CONV_W):
        y = y + hp[:, j:j + s] * w[j]
    return y + bias


def setup_inputs(seed: int = 0) -> dict:
    key = jax.random.key(seed)
    ks = jax.random.split(key, 24)
    f32 = jnp.float32
    nrm = lambda k, shape, sc: jax.random.normal(k, shape, f32) * sc
    L, D = DEPTH, D_MODEL
    w_in = jnp.concatenate([
        nrm(ks[0], (L, D, D_ATTN), D ** -0.5),
        nrm(ks[1], (L, D, D_ATTN), D ** -0.5),
        nrm(ks[2], (L, D, D_ATTN), D ** -0.5 * BETA),
        nrm(ks[3], (L, D, D_POOL), D ** -0.5),
        nrm(ks[4], (L, D, 2 * D), D ** -0.5),
    ], axis=-1)
    return {
        "x": jax.random.normal(ks[5], (BATCH, SEQ, D), f32),
        "p": jax.random.normal(ks[6], (DEPTH, BATCH, SEQ, PLE_DIM), f32),
        "ln_in_g": 1.0 + nrm(ks[7], (D,), 0.02),
        "ln_in_b": nrm(ks[8], (D,), 0.02),
        "w_in": w_in,
        "b_in": nrm(ks[9], (L, N_PROJ), 0.01),
        "rpb": nrm(ks[10], (L, N_HEADS, 2 * KH_MAX - 1, 2 * KW - 1), 0.02),
        "w_attn_out": nrm(ks[11], (L, D_ATTN, D), D_ATTN ** -0.5 * BETA),
        "pool_w": nrm(ks[12], (L, POOL_GROUPS, POOL_GROUP_DIM, POOL_GROUP_DIM), POOL_GROUP_DIM ** -0.5),
        "pool_scale": 1.0 + nrm(ks[13], (L, D_POOL), 0.02),
        "w_pool_out": nrm(ks[14], (L, D_POOL, D), D_POOL ** -0.5 * BETA),
        "w_mix_out": nrm(ks[15], (L, D, D), D ** -0.5 * BETA),
        "ln1_g": 1.0 + nrm(ks[16], (L, D), 0.02),
        "ln1_b": nrm(ks[17], (L, D), 0.02),
        "w_up": nrm(ks[18], (L, D, 2 * D_FF), D ** -0.5),
        "conv_w": nrm(ks[19], (L, CONV_W, D_FF), CONV_W ** -0.5),
        "conv_b": nrm(ks[20], (L, D_FF), 0.01),
        "w_down": nrm(ks[21], (L, D_FF, D), D_FF ** -0.5 * BETA),
        "w_ple_gate": nrm(ks[22], (L, D, D), D ** -0.5),
        "w_ple_proj": nrm(ks[23], (L, PLE_DIM, D), PLE_DIM ** -0.5 * BETA),
        "ln2_g": 1.0 + nrm(jax.random.fold_in(key, 100), (L, D), 0.02),
        "ln2_b": nrm(jax.random.fold_in(key, 101), (L, D), 0.02),
    }


def reference(x, p, ln_in_g, ln_in_b, w_in, b_in, rpb, w_attn_out, pool_w, pool_scale,
              w_pool_out, w_mix_out, ln1_g, ln1_b, w_up, conv_w, conv_b, w_down,
              w_ple_gate, w_ple_proj, ln2_g, ln2_b):
    b, s, _ = x.shape
    splits = [D_ATTN, 2 * D_ATTN, 3 * D_ATTN, 3 * D_ATTN + D_POOL, 3 * D_ATTN + D_POOL + D_MODEL]
    h = layer_norm(x, ln_in_g, ln_in_b)
    for i in range(DEPTH):
        proj = h @ w_in[i] + b_in[i]
        q, k, v, u_pool, g_a, g_b = jnp.split(proj, splits, axis=-1)
        y_attn = neighbourhood_attention(q, k, v, rpb[i]) @ w_attn_out[i]
        pooled = multiscale_pool(u_pool).reshape(b, s, POOL_GROUPS, POOL_GROUP_DIM)
        pooled = jnp.einsum('bsgc,gcd->bsgd', pooled, pool_w[i]).reshape(b, s, D_POOL) * pool_scale[i]
        y_pool = pooled @ w_pool_out[i]
        merged = jax.nn.sigmoid(g_a) * y_attn + jax.nn.sigmoid(g_b) * y_pool
        h = layer_norm(ALPHA * h + merged @ w_mix_out[i], ln1_g[i], ln1_b[i])
        h_val, h_gate = jnp.split(h @ w_up[i], 2, axis=-1)
        act = jax.nn.gelu(dwconv_centred(h_gate, conv_w[i], conv_b[i]), approximate=False)
        ffn = (act * h_val) @ w_down[i]
        ple = jax.nn.sigmoid(h @ w_ple_gate[i]) * (p[i] @ w_ple_proj[i])
        h = layer_norm(ALPHA * h + ffn + ple, ln2_g[i], ln2_b[i])
    return h
```

```cpp
#include <hip/hip_runtime.h>
#include <cstdio>
#include <cstdint>

#define LAS __attribute__((address_space(3)))
typedef _Float16 f16;
typedef _Float16 f16x8 __attribute__((ext_vector_type(8)));
typedef _Float16 f16x4 __attribute__((ext_vector_type(4)));
typedef _Float16 f16x2 __attribute__((ext_vector_type(2)));
typedef float f32x4 __attribute__((ext_vector_type(4)));
typedef float f32x2 __attribute__((ext_vector_type(2)));
typedef unsigned u32x4 __attribute__((ext_vector_type(4)));
typedef unsigned u32x2 __attribute__((ext_vector_type(2)));

constexpr int DM = 1024, NB = 8, SEQ = 2048, M = NB * SEQ, DEPTH = 4, NH = 8, HD = 64, DA = 512, DP = 512, DFF = 2816, PLE = 256, NPROJ = 4096;
constexpr int GW = 64, ROWS = SEQ / GW;
constexpr float ALPHA = 1.681792830507429f;
constexpr float LN_EPS = 1e-5f;
constexpr int NWAVES = 8, NTHREADS = 512;

constexpr size_t MiB = 1u << 20;
constexpr size_t WS_CTL = 0, CTL_ZERO_BYTES = 1 * MiB;
constexpr size_t WS_W = 4 * MiB;
constexpr size_t W_IN = WS_W, W_A = WS_W + 8 * MiB, W_PC = WS_W + 9 * MiB, W_MIX = WS_W + 10 * MiB, W_UP = WS_W + 12 * MiB, W_D = WS_W + 23 * MiB, W_G = WS_W + 29 * MiB, W_P = WS_W + 31 * MiB;
constexpr size_t WS_H16 = 36 * MiB, WS_P16 = 68 * MiB, WS_PLE = 76 * MiB, WS_BIG = 108 * MiB;
constexpr size_t B_Q = WS_BIG, B_K = WS_BIG + 16 * MiB, B_U = WS_BIG + 32 * MiB, B_VT = WS_BIG + 48 * MiB, B_SG = WS_BIG + 64 * MiB, B_ATT = WS_BIG + 128 * MiB, B_PD = WS_BIG + 144 * MiB, B_MRG = WS_BIG + 160 * MiB;
constexpr size_t B_VAL = WS_BIG, B_GATE = WS_BIG + 88 * MiB;
constexpr size_t WS_END = 300 * MiB;
constexpr int CW_BAR = 4096;

constexpr int RING_BYTES = 131072, LDSCTL_OFF = RING_BYTES, MISC_OFF = LDSCTL_OFF + 320, LDS_BYTES = 147456;

#define VM_WAIT() asm volatile("s_waitcnt vmcnt(0)" ::: "memory")
#define LDS_WAIT() asm volatile("s_waitcnt lgkmcnt(0)" ::: "memory")

#define XB_TMO      128
#define XB_XCNT(j)  (256  + 64 * (j))
#define XB_XSUB(j)  (1280 + 64 * (j))
#define XB_XGEN(j)  (2304 + 64 * (j))
#define XB_TOP      3328
#define XB_TOPGEN   3392
#define XCD_BAR_WORDS 3456
#define XB_SPIN_CAP (1u << 20)
__device__ __forceinline__ unsigned xb_ld(unsigned* p)              { return __hip_atomic_load(p, __ATOMIC_RELAXED, __HIP_MEMORY_SCOPE_AGENT); }
__device__ __forceinline__ unsigned xb_add(unsigned* p, unsigned v) { return __hip_atomic_fetch_add(p, v, __ATOMIC_RELAXED, __HIP_MEMORY_SCOPE_AGENT); }
__device__ __forceinline__ unsigned xb_xcc_id() { return (unsigned)__builtin_amdgcn_s_getreg((3 << 11) | 20) & 0xFu; }
#define XB_SPIN(cond, bar) do { unsigned _sp = 0; while (cond) { __builtin_amdgcn_s_sleep(1); \
    if ((++_sp & 255u) == 0u) { if (xb_ld(&(bar)[XB_TMO])) break; if (_sp > XB_SPIN_CAP) { atomicAdd(&(bar)[XB_TMO], 1u); break; } } } } while (0)
struct XcdBarrier { unsigned* bar; unsigned x; volatile LAS unsigned* st; };
__device__ __forceinline__ XcdBarrier xcd_barrier_post(unsigned* bar, volatile LAS unsigned* st) {
    XcdBarrier b; b.bar = bar; b.x = xb_xcc_id(); b.st = st;
    if (threadIdx.x == 0) (void)xb_add(&bar[XB_XCNT(b.x)], 1u);
    return b;
}
__device__ __forceinline__ void xcd_barrier_complete(unsigned* bar, unsigned x, unsigned& nloc, unsigned& nx) {
    const unsigned G = gridDim.x * gridDim.y * gridDim.z;
    unsigned sum, cnt, mine, sp = 0u;
    for (;;) {
        sum = 0u; cnt = 0u; mine = 0u;
#pragma unroll
        for (unsigned j = 0; j < 16; ++j) { const unsigned c = xb_ld(&bar[XB_XCNT(j)]); sum += c; cnt += (c > 0u) ? 1u : 0u; mine = (j == x) ? c : mine; }
        if (sum == G) break;
        __builtin_amdgcn_s_sleep(1);
        if ((++sp & 255u) == 0u) { if (xb_ld(&bar[XB_TMO])) break; if (sp > XB_SPIN_CAP) { atomicAdd(&bar[XB_TMO], 1u); break; } }
    }
    nloc = mine > 0u ? mine : 1u; nx = cnt > 0u ? cnt : 1u;
}
__device__ __forceinline__ void xcd_barrier(const XcdBarrier& b) {
    asm volatile("s_waitcnt vmcnt(0)" ::: "memory");
    __syncthreads();
    if (threadIdx.x == 0) {
        unsigned* bar = b.bar;
        __builtin_amdgcn_s_waitcnt(0);
        unsigned nloc = b.st[0], nx = b.st[1];
        if (nloc == 0u) { xcd_barrier_complete(bar, b.x, nloc, nx); b.st[0] = nloc; b.st[1] = nx; }
        const unsigned old = xb_add(&bar[XB_XSUB(b.x)], 1u);
        const unsigned gen = old / nloc;
        if (old + 1u == (gen + 1u) * nloc) {
            __builtin_amdgcn_fence(__ATOMIC_RELEASE, "agent");
            asm volatile("s_waitcnt vmcnt(0)" ::: "memory");
            const unsigned og = xb_add(&bar[XB_TOP], 1u);
            const unsigned tg = og / nx;
            if (og + 1u == (tg + 1u) * nx) xb_add(&bar[XB_TOPGEN], 1u);
            else XB_SPIN(xb_ld(&bar[XB_TOPGEN]) == tg, bar);
            __builtin_amdgcn_fence(__ATOMIC_ACQUIRE, "agent");
            xb_add(&bar[XB_XGEN(b.x)], 1u);
            asm volatile("s_waitcnt vmcnt(0)" ::: "memory");
        } else {
            XB_SPIN(xb_ld(&bar[XB_XGEN(b.x)]) == gen, bar);
            __builtin_amdgcn_fence(__ATOMIC_ACQUIRE, "agent");
            asm volatile("s_waitcnt vmcnt(0)" ::: "memory");
        }
    }
    __syncthreads();
}

namespace pg8 {
constexpr int BM = 256, BK = 64, HALF = 128, HTB = HALF * BK * 2, NXCD = 8, WGM = 8;
__host__ __device__ __forceinline__ int lds_byte(int r, int c) { const int st = (r >> 4) * 2 + (c >> 5), rr = r & 15, cc = c & 31, ob = rr * 64 + cc * 2; return st * 1024 + (ob ^ (((ob >> 9) & 1) << 5)); }
__host__ __device__ __forceinline__ void stage_rc(int b, int& R, int& C) { const int st = b / 1024, sb = b % 1024, swz = sb ^ (((sb >> 9) & 1) << 5); R = (st >> 1) * 16 + swz / 64; C = (st & 1) * 32 + (swz % 64) / 2; }
__host__ __device__ __forceinline__ int perm32(int rho) { const int n = rho >> 4, i = rho & 15; return 8 * (i >> 2) + 4 * n + (i & 3); }

__device__ __forceinline__ void tile_order(int nM, int nN, int L, int& pm, int& pn) {
    const int nwg = nM * nN; int wgid = L;
    { const int q = nwg / NXCD, r = nwg % NXCD, xcd = wgid % NXCD, off = wgid / NXCD; wgid = (xcd < r ? xcd * (q + 1) : r * (q + 1) + (xcd - r) * q) + off; }
    const int nig = WGM * nN, gid = wgid / nig, fm = gid * WGM, gsz = (nM - fm) < WGM ? (nM - fm) : WGM;
    pm = fm + ((wgid % nig) % gsz); pn = (wgid % nig) / gsz;
}

struct GUnit { const char* A; const char* B; int K; int kind; int pm; int pn; };

template <class Sched, class Epi>
__device__ __forceinline__ void gemm_phase(LAS unsigned char* lds, const Sched& S, const Epi& E) {
    const int tid = threadIdx.x, wid = __builtin_amdgcn_readfirstlane(tid >> 6), lane = tid & 63, wr = wid >> 2, wc = wid & 3, fr = lane & 15, fq = lane >> 4;
    int R0, C0; stage_rc(tid * 16, R0, C0);
    const unsigned ra = (unsigned)R0, rb = (unsigned)((R0 & ~31) + perm32(R0 & 31)), c2 = (unsigned)C0 * 2u;
    const size_t kstep = (size_t)(BK * 2);
    const unsigned ldsw = (unsigned)wid * 1024u;
    const int aoff = lds_byte(wr * 64 + fr, fq * 8), boff = lds_byte(wc * 32 + fr, fq * 8);
#define PG8_SA(b, h) (((b) * 2 + (h)) * HTB)
#define PG8_SB(b, h) ((4 + (b) * 2 + (h)) * HTB)
#define PG8_STAGE(bufoff, gbase, voff, h64) do { \
        __builtin_amdgcn_global_load_lds((const unsigned*)((const char*)(gbase) + (voff)), (LAS unsigned*)(lds + (bufoff) + ldsw), 16, 0, 0); \
        __builtin_amdgcn_global_load_lds((const unsigned*)((const char*)(gbase) + (h64) + (voff)), (LAS unsigned*)(lds + (bufoff) + ldsw + 8192), 16, 0, 0); } while (0)
#define PG8_LDA(dst, b, h) do { _Pragma("unroll") for (int m = 0; m < 4; ++m) _Pragma("unroll") for (int k = 0; k < 2; ++k) dst[m][k] = *(const LAS f16x8*)(lds + PG8_SA(b, h) + aoff + m * 2048 + k * 1024); } while (0)
#define PG8_LDB(dst, b, h) do { _Pragma("unroll") for (int n = 0; n < 2; ++n) _Pragma("unroll") for (int k = 0; k < 2; ++k) dst[n][k] = *(const LAS f16x8*)(lds + PG8_SB(b, h) + boff + n * 2048 + k * 1024); } while (0)
#define PG8_MMA(ai, bj, At, Bt) do { __builtin_amdgcn_s_setprio(1); _Pragma("unroll") for (int m = 0; m < 4; ++m) _Pragma("unroll") for (int n = 0; n < 2; ++n) _Pragma("unroll") for (int k = 0; k < 2; ++k) \
        acc[ai][bj][m][n] = __builtin_amdgcn_mfma_f32_16x16x32_f16(Bt[n][k], At[m][k], acc[ai][bj][m][n], 0, 0, 0); __builtin_amdgcn_s_setprio(0); } while (0)
#define PG8_WAIT_V(n) asm volatile("s_waitcnt vmcnt(" #n ")" ::: "memory")
#define PG8_WAIT_L(n) asm volatile("s_waitcnt lgkmcnt(" #n ")" ::: "memory")
#define PG8_BAR __builtin_amdgcn_s_barrier()
#define PG8_SCHED __builtin_amdgcn_sched_barrier(0)
    GUnit cur, nxt; int ui = 0;
    if (!S.next(0, cur)) return;
    f32x4 acc[2][2][4][2];
#pragma unroll
    for (int a = 0; a < 2; ++a)
#pragma unroll
        for (int b = 0; b < 2; ++b)
#pragma unroll
            for (int m = 0; m < 4; ++m)
#pragma unroll
                for (int n = 0; n < 2; ++n) acc[a][b][m][n] = (f32x4){0.f, 0.f, 0.f, 0.f};
    f16x8 At[4][2], B0[2][2], B1[2][2];
    const char* cA = cur.A; const char* cB = cur.B;
    unsigned cK2 = (unsigned)cur.K * 2u;
    unsigned cvA = ra * cK2 + c2, cvB = rb * cK2 + c2;
    size_t ch64 = (size_t)64 * cK2, chs = (size_t)128 * cK2;
    PG8_STAGE(PG8_SB(0, 0), cB, cvB, ch64); PG8_STAGE(PG8_SB(0, 1), cB + chs, cvB, ch64); PG8_STAGE(PG8_SA(0, 0), cA, cvA, ch64); PG8_STAGE(PG8_SA(0, 1), cA + chs, cvA, ch64);
    if (wr == 1) PG8_BAR;
    PG8_WAIT_V(2); PG8_BAR;
    PG8_STAGE(PG8_SB(1, 0), cB + kstep, cvB, ch64); PG8_STAGE(PG8_SA(1, 0), cA + kstep, cvA, ch64); PG8_STAGE(PG8_SB(1, 1), cB + chs + kstep, cvB, ch64);
    PG8_WAIT_V(6); PG8_BAR;
    for (;;) {
        const bool has_next = S.next(ui + 1, nxt);
        const char* nA = has_next ? nxt.A : cA; const char* nB = has_next ? nxt.B : cB;
        const unsigned nK2 = has_next ? (unsigned)nxt.K * 2u : cK2;
        const unsigned nvA = ra * nK2 + c2, nvB = rb * nK2 + c2;
        const size_t nh64 = (size_t)64 * nK2, nhs = (size_t)128 * nK2;
        const int nt = (int)(cK2 >> 7);
        for (int t = 0; t < nt; t += 2) {
            const bool last = (t == nt - 2);
            const char* a1 = cA + (size_t)(t + 1) * kstep;
            const char* a2 = last ? nA : cA + (size_t)(t + 2) * kstep; const char* b2 = last ? nB : cB + (size_t)(t + 2) * kstep;
            const char* a3 = a2 + kstep; const char* b3 = b2 + kstep;
            const unsigned vA2 = last ? nvA : cvA, vB2 = last ? nvB : cvB;
            const size_t h2 = last ? nh64 : ch64, hs2 = last ? nhs : chs;
            PG8_LDB(B0, 0, 0); PG8_LDB(B1, 0, 1); PG8_SCHED; PG8_LDA(At, 0, 0); PG8_STAGE(PG8_SA(1, 1), a1 + chs, cvA, ch64);
            PG8_WAIT_V(8); PG8_WAIT_L(0); PG8_BAR; PG8_MMA(0, 0, At, B0); PG8_MMA(0, 1, At, B1); PG8_BAR; PG8_SCHED;
            PG8_LDA(At, 0, 1); PG8_STAGE(PG8_SB(0, 0), b2, vB2, h2); PG8_STAGE(PG8_SB(0, 1), b2 + hs2, vB2, h2); PG8_STAGE(PG8_SA(0, 0), a2, vA2, h2);
            PG8_WAIT_V(8); PG8_WAIT_L(0); PG8_BAR; PG8_MMA(1, 0, At, B0); PG8_MMA(1, 1, At, B1); PG8_BAR; PG8_SCHED;
            PG8_LDB(B0, 1, 0); PG8_LDB(B1, 1, 1); PG8_SCHED; PG8_LDA(At, 1, 0); PG8_STAGE(PG8_SA(0, 1), a2 + hs2, vA2, h2);
            PG8_WAIT_V(8); PG8_WAIT_L(0); PG8_BAR; PG8_MMA(0, 0, At, B0); PG8_MMA(0, 1, At, B1); PG8_BAR; PG8_SCHED;
            PG8_LDA(At, 1, 1); PG8_STAGE(PG8_SB(1, 0), b3, vB2, h2); PG8_STAGE(PG8_SB(1, 1), b3 + hs2, vB2, h2); PG8_STAGE(PG8_SA(1, 0), a3, vA2, h2);
            PG8_WAIT_V(8); PG8_WAIT_L(0); PG8_BAR; PG8_MMA(1, 0, At, B0); PG8_MMA(1, 1, At, B1); PG8_BAR; PG8_SCHED;
        }
        if (wr == 0) PG8_BAR;
        E(acc, cur, wr, wc, fr, fq);
        if (!has_next) break;
#pragma unroll
        for (int a = 0; a < 2; ++a)
#pragma unroll
            for (int b = 0; b < 2; ++b)
#pragma unroll
                for (int m = 0; m < 4; ++m)
#pragma unroll
                    for (int n = 0; n < 2; ++n) acc[a][b][m][n] = (f32x4){0.f, 0.f, 0.f, 0.f};
        cur = nxt; cA = nA; cB = nB; cK2 = nK2; cvA = nvA; cvB = nvB; ch64 = nh64; chs = nhs; ++ui;
        if (wr == 1) PG8_BAR;
    }
    PG8_WAIT_V(0);
    PG8_BAR;
#undef PG8_SA
#undef PG8_SB
#undef PG8_STAGE
#undef PG8_LDA
#undef PG8_LDB
#undef PG8_MMA
#undef PG8_WAIT_V
#undef PG8_WAIT_L
#undef PG8_BAR
#undef PG8_SCHED
}
}
using pg8::GUnit;

enum Kind { K_Q = 0, K_K, K_U, K_SG, K_VT, K_Y1, K_Y2, K_MIX, K_VAL, K_GATE, K_PP, K_PG, K_DOWN };

__device__ __forceinline__ unsigned pk_f16(float lo, float hi) { f16x2 h = {(f16)lo, (f16)hi}; return __builtin_bit_cast(unsigned, h); }
__device__ __forceinline__ u32x4 pk8(const f32x4 v0, const f32x4 v1) { u32x4 w; w.x = pk_f16(v0[0], v0[1]); w.y = pk_f16(v0[2], v0[3]); w.z = pk_f16(v1[0], v1[1]); w.w = pk_f16(v1[2], v1[3]); return w; }
__device__ __forceinline__ void unpk8(const u32x4 w, f32x4& v0, f32x4& v1) {
    const f16x8 h = __builtin_bit_cast(f16x8, w);
    v0 = (f32x4){(float)h[0], (float)h[1], (float)h[2], (float)h[3]}; v1 = (f32x4){(float)h[4], (float)h[5], (float)h[6], (float)h[7]};
}
__device__ __forceinline__ float sigmoidf_(float x) { return __builtin_amdgcn_rcpf(1.0f + __expf(-x)); }
__device__ __forceinline__ f32x4 sig4(const f32x4 v) { return (f32x4){sigmoidf_(v[0]), sigmoidf_(v[1]), sigmoidf_(v[2]), sigmoidf_(v[3])}; }

struct Epi {
    unsigned char* ws; float* out; const float* b_in;
    __device__ __forceinline__ void operator()(const f32x4 (&acc)[2][2][4][2], const GUnit& u, int wr, int wc, int fr, int fq) const {
        const int kind = u.kind;
        const int rl0 = wr * 64 + fr, cl0 = wc * 32 + 8 * fq;
        const int grow0 = u.pm * 256 + rl0, gcol0 = u.pn * 256 + cl0;
        if (kind <= K_SG) {
            f16* base; int ldc, col0; const float* bias = b_in + gcol0;
            if (kind == K_Q)      { base = (f16*)(ws + B_Q); ldc = 512; col0 = gcol0; }
            else if (kind == K_K) { base = (f16*)(ws + B_K); ldc = 512; col0 = gcol0 - 512; }
            else if (kind == K_U) { base = (f16*)(ws + B_U); ldc = 512; col0 = gcol0 - 1536; }
            else                  { base = (f16*)(ws + B_SG); ldc = 2048; col0 = gcol0 - 2048; }
            f32x4 bv[2][2];
#pragma unroll
            for (int bj = 0; bj < 2; ++bj)
#pragma unroll
                for (int n = 0; n < 2; ++n) bv[bj][n] = *(const f32x4*)(bias + bj * 128 + 4 * n);
#pragma unroll
            for (int ai = 0; ai < 2; ++ai)
#pragma unroll
                for (int m = 0; m < 4; ++m) { f16* rowp = base + (size_t)(grow0 + ai * 128 + m * 16) * ldc + col0;
#pragma unroll
                    for (int bj = 0; bj < 2; ++bj) { f32x4 v0 = acc[ai][bj][m][0] + bv[bj][0], v1 = acc[ai][bj][m][1] + bv[bj][1];
                        if (kind == K_SG) { v0 = sig4(v0); v1 = sig4(v1); }
                        *(u32x4*)(rowp + bj * 128) = pk8(v0, v1); } }
        } else if (kind == K_VT) {
            f16* base = (f16*)(ws + B_VT);
#pragma unroll
            for (int ai = 0; ai < 2; ++ai)
#pragma unroll
                for (int m = 0; m < 4; ++m) { const int row = grow0 + ai * 128 + m * 16; const float bz = b_in[1024 + row]; f16* rowp = base + (size_t)row * M + gcol0;
#pragma unroll
                    for (int bj = 0; bj < 2; ++bj) *(u32x4*)(rowp + bj * 128) = pk8(acc[ai][bj][m][0] + bz, acc[ai][bj][m][1] + bz); }
        } else if (kind == K_Y1 || kind == K_Y2) {
            f16* mrg = (f16*)(ws + B_MRG); const f16* sg = (const f16*)(ws + B_SG) + (kind == K_Y2 ? 1024 : 0);
#pragma unroll
            for (int ai = 0; ai < 2; ++ai)
#pragma unroll
                for (int m = 0; m < 4; ++m) { const size_t row = (size_t)(grow0 + ai * 128 + m * 16);
#pragma unroll
                    for (int bj = 0; bj < 2; ++bj) { const int col = gcol0 + bj * 128;
                        f32x4 g0, g1; unpk8(*(const u32x4*)(sg + row * 2048 + col), g0, g1);
                        f32x4 v0 = acc[ai][bj][m][0] * g0, v1 = acc[ai][bj][m][1] * g1;
                        if (kind == K_Y2) { f32x4 p0, p1; unpk8(*(const u32x4*)(mrg + row * 1024 + col), p0, p1); v0 += p0; v1 += p1; }
                        *(u32x4*)(mrg + row * 1024 + col) = pk8(v0, v1); } }
        } else if (kind == K_MIX || kind == K_DOWN) {
            const f16* ple = (const f16*)(ws + WS_PLE);
#pragma unroll
            for (int ai = 0; ai < 2; ++ai)
#pragma unroll
                for (int m = 0; m < 4; ++m) { const size_t row = (size_t)(grow0 + ai * 128 + m * 16);
#pragma unroll
                    for (int bj = 0; bj < 2; ++bj) { const int col = gcol0 + bj * 128; float* o = out + row * 1024 + col;
                        f32x4 v0 = acc[ai][bj][m][0] + ALPHA * *(const f32x4*)o, v1 = acc[ai][bj][m][1] + ALPHA * *(const f32x4*)(o + 4);
                        if (kind == K_DOWN) { f32x4 p0, p1; unpk8(*(const u32x4*)(ple + row * 1024 + col), p0, p1); v0 += p0; v1 += p1; }
                        *(f32x4*)o = v0; *(f32x4*)(o + 4) = v1; } }
        } else if (kind == K_VAL || kind == K_GATE) {
            f16* base = (f16*)(ws + (kind == K_VAL ? B_VAL : B_GATE)); const int col0 = gcol0 - (kind == K_GATE ? DFF : 0);
#pragma unroll
            for (int ai = 0; ai < 2; ++ai)
#pragma unroll
                for (int m = 0; m < 4; ++m) { f16* rowp = base + (size_t)(grow0 + ai * 128 + m * 16) * DFF + col0;
#pragma unroll
                    for (int bj = 0; bj < 2; ++bj) *(u32x4*)(rowp + bj * 128) = pk8(acc[ai][bj][m][0], acc[ai][bj][m][1]); }
        } else {
            f16* ple = (f16*)(ws + WS_PLE);
#pragma unroll
            for (int ai = 0; ai < 2; ++ai)
#pragma unroll
                for (int m = 0; m < 4; ++m) { f16* rowp = ple + (size_t)(grow0 + ai * 128 + m * 16) * 1024 + gcol0;
#pragma unroll
                    for (int bj = 0; bj < 2; ++bj) { f32x4 v0 = acc[ai][bj][m][0], v1 = acc[ai][bj][m][1];
                        if (kind == K_PG) { f32x4 p0, p1; unpk8(*(const u32x4*)(rowp + bj * 128), p0, p1); v0 = sig4(v0) * p0; v1 = sig4(v1) * p1; }
                        *(u32x4*)(rowp + bj * 128) = pk8(v0, v1); } }
        }
    }
};

enum Phase { PH_A = 0, PH_C, PH_D, PH_E, PH_F };
struct Sched {
    int phase, c, G; unsigned char* ws;
    __device__ __forceinline__ bool next(int i, GUnit& u) const {
        const char* w = (const char*)ws;
        if (phase == PH_A) {
            const int L = i * G + c; if (L >= 1024) return false;
            if (L < 896) { int pm, j; pg8::tile_order(64, 14, L, pm, j); const int pn = j < 4 ? j : j + 2;
                u.A = w + WS_H16 + (size_t)pm * 256 * 1024 * 2; u.B = w + W_IN + (size_t)pn * 256 * 1024 * 2; u.K = 1024; u.pm = pm; u.pn = pn;
                u.kind = pn < 2 ? K_Q : (pn < 4 ? K_K : (pn < 8 ? K_U : K_SG)); }
            else { int pm, pn; pg8::tile_order(2, 64, L - 896, pm, pn);
                u.A = w + W_IN + (size_t)(1024 + pm * 256) * 1024 * 2; u.B = w + WS_H16 + (size_t)pn * 256 * 1024 * 2; u.K = 1024; u.pm = pm; u.pn = pn; u.kind = K_VT; }
            return true;
        } else if (phase == PH_C) {
            if (i >= 2 || c >= 256) return false;
            int pm, pn; pg8::tile_order(64, 4, c, pm, pn); u.pm = pm; u.pn = pn; u.K = 512;
            if (i == 0) { u.A = w + B_ATT + (size_t)pm * 256 * 512 * 2; u.B = w + W_A + (size_t)pn * 256 * 512 * 2; u.kind = K_Y1; }
            else        { u.A = w + B_PD + (size_t)pm * 256 * 512 * 2; u.B = w + W_PC + (size_t)pn * 256 * 512 * 2; u.kind = K_Y2; }
            return true;
        } else if (phase == PH_D) {
            if (i >= 1 || c >= 256) return false;
            int pm, pn; pg8::tile_order(64, 4, c, pm, pn); u.pm = pm; u.pn = pn; u.K = 1024;
            u.A = w + B_MRG + (size_t)pm * 256 * 1024 * 2; u.B = w + W_MIX + (size_t)pn * 256 * 1024 * 2; u.kind = K_MIX; return true;
        } else if (phase == PH_E) {
            if (i < 2) { if (c >= 256) return false; int pm, pn; pg8::tile_order(64, 4, c, pm, pn); u.pm = pm; u.pn = pn;
                if (i == 0) { u.K = 256; u.A = w + WS_P16 + (size_t)pm * 256 * 256 * 2; u.B = w + W_P + (size_t)pn * 256 * 256 * 2; u.kind = K_PP; }
                else        { u.K = 1024; u.A = w + WS_H16 + (size_t)pm * 256 * 1024 * 2; u.B = w + W_G + (size_t)pn * 256 * 1024 * 2; u.kind = K_PG; }
                return true; }
            const int L = (i - 2) * G + c; if (L >= 1408) return false;
            int pm, pn; pg8::tile_order(64, 22, L, pm, pn); u.pm = pm; u.pn = pn; u.K = 1024;
            u.A = w + WS_H16 + (size_t)pm * 256 * 1024 * 2; u.B = w + W_UP + (size_t)pn * 256 * 1024 * 2; u.kind = pn < 11 ? K_VAL : K_GATE; return true;
        } else {
            if (i >= 1 || c >= 256) return false;
            int pm, pn; pg8::tile_order(64, 4, c, pm, pn); u.pm = pm; u.pn = pn; u.K = DFF;
            u.A = w + B_VAL + (size_t)pm * 256 * DFF * 2; u.B = w + W_D + (size_t)pn * 256 * DFF * 2; u.kind = K_DOWN; return true;
        }
    }
};

__device__ __forceinline__ float wave_sum(float v) {
#pragma unroll
    for (int o = 1; o < 64; o <<= 1) v += __shfl_xor(v, o);
    return v;
}
__device__ __forceinline__ void transpose_item(const float* W, int ldw, int K, int nblk, f16* WT, LAS float* scr, int item, int lane) {
    const int kb = item / nblk, nb = item % nblk, k0 = 64 * kb, n0 = 32 * nb;
#pragma unroll 8
    for (int i = 0; i < 32; ++i) { const int kk = 2 * i + (lane >> 5); scr[kk * 33 + (lane & 31)] = W[(size_t)(k0 + kk) * ldw + n0 + (lane & 31)]; }
    LDS_WAIT(); asm volatile("" ::: "memory");
    const int c = lane & 7;
#pragma unroll
    for (int j = 0; j < 4; ++j) { const int n = (lane >> 3) + 8 * j; const LAS float* s = scr + (8 * c) * 33 + n;
        u32x4 o; o.x = pk_f16(s[0 * 33], s[1 * 33]); o.y = pk_f16(s[2 * 33], s[3 * 33]); o.z = pk_f16(s[4 * 33], s[5 * 33]); o.w = pk_f16(s[6 * 33], s[7 * 33]);
        *(u32x4*)(WT + (size_t)(n0 + n) * K + k0 + 8 * c) = o; }
    LDS_WAIT(); asm volatile("" ::: "memory");
}
__device__ __forceinline__ void ln_row(const float* xrow, const float* g, const float* b, float* orow, f16* hrow, int lane) {
    const f32x4* xr = (const f32x4*)xrow + lane;
    f32x4 v[4]; float s = 0.f;
#pragma unroll
    for (int j = 0; j < 4; ++j) { v[j] = xr[64 * j]; s += (v[j].x + v[j].y) + (v[j].z + v[j].w); }
    const float mean = wave_sum(s) * (1.f / DM); float s2 = 0.f;
#pragma unroll
    for (int j = 0; j < 4; ++j) { v[j] = v[j] - mean; s2 += (v[j].x * v[j].x + v[j].y * v[j].y) + (v[j].z * v[j].z + v[j].w * v[j].w); }
    const float rstd = 1.f / sqrtf(wave_sum(s2) * (1.f / DM) + LN_EPS);
#pragma unroll
    for (int j = 0; j < 4; ++j) { const f32x4 gg = ((const f32x4*)g)[lane + 64 * j], bb = ((const f32x4*)b)[lane + 64 * j]; const f32x4 y = v[j] * rstd * gg + bb;
        ((f32x4*)orow)[lane + 64 * j] = y; u32x2 w; w.x = pk_f16(y.x, y.y); w.y = pk_f16(y.z, y.w); ((u32x2*)hrow)[lane + 64 * j] = w; }
}

__device__ __forceinline__ void attn_wave_unit(const f16* __restrict__ Q, const f16* __restrict__ Kb, const f16* __restrict__ VT, f16* __restrict__ ATT, const LAS float* bias, int b, int r, int h, int qb, int lane) {
    const int i = lane & 15, g = lane >> 4;
    const int c0q = qb * 16, c0k = min(max(c0q - 8, 0), 32), rs = min(max(r - 4, 0), ROWS - 8);
    const int qc = c0q + i, cs = min(max(qc - 8, 0), GW - 16);
    const f16* qp = Q + (size_t)(b * SEQ + r * GW + qc) * DA + h * HD + 8 * g;
    const f16x8 qf0 = *(const f16x8*)qp, qf1 = *(const f16x8*)(qp + 32);
    f32x4 st[8][2];
#pragma unroll
    for (int kr = 0; kr < 8; ++kr) {
        const f16* kp = Kb + (size_t)(b * SEQ + (rs + kr) * GW + c0k + i) * DA + h * HD + 8 * g;
#pragma unroll
        for (int ct = 0; ct < 2; ++ct) {
            const f16x8 k0 = *(const f16x8*)(kp + ct * 16 * DA), k1 = *(const f16x8*)(kp + ct * 16 * DA + 32);
            f32x4 a = (f32x4){0.f, 0.f, 0.f, 0.f};
            a = __builtin_amdgcn_mfma_f32_16x16x32_f16(k0, qf0, a, 0, 0, 0);
            a = __builtin_amdgcn_mfma_f32_16x16x32_f16(k1, qf1, a, 0, 0, 0);
            st[kr][ct] = a;
        }
    }
    float mx = -1e30f;
#pragma unroll
    for (int kr = 0; kr < 8; ++kr) {
        const LAS float* brow = bias + (h * 15 + (rs + kr - r + 7)) * 31;
#pragma unroll
        for (int ct = 0; ct < 2; ++ct)
#pragma unroll
            for (int e = 0; e < 4; ++e) {
                const int kc = c0k + 16 * ct + 4 * g + e; const bool valid = (kc >= cs) && (kc < cs + 16);
                const int co = min(max(kc - qc + 15, 0), 30);
                float s = st[kr][ct][e] * 0.125f + brow[co];
                s = valid ? s : -1e30f; st[kr][ct][e] = s; mx = fmaxf(mx, s);
            }
    }
    mx = fmaxf(mx, __shfl_xor(mx, 16)); mx = fmaxf(mx, __shfl_xor(mx, 32));
    float sum = 0.f;
#pragma unroll
    for (int kr = 0; kr < 8; ++kr)
#pragma unroll
        for (int ct = 0; ct < 2; ++ct)
#pragma unroll
            for (int e = 0; e < 4; ++e) { const float p = __expf(st[kr][ct][e] - mx); st[kr][ct][e] = p; sum += p; }
    sum += __shfl_xor(sum, 16); sum += __shfl_xor(sum, 32);
    f32x4 o[4];
#pragma unroll
    for (int dt = 0; dt < 4; ++dt) o[dt] = (f32x4){0.f, 0.f, 0.f, 0.f};
#pragma unroll
    for (int kr = 0; kr < 8; ++kr) {
        f16x8 pf;
#pragma unroll
        for (int e = 0; e < 4; ++e) { pf[e] = (f16)st[kr][0][e]; pf[4 + e] = (f16)st[kr][1][e]; }
#pragma unroll
        for (int dt = 0; dt < 4; ++dt) {
            const f16* vp = VT + (size_t)(h * HD + 16 * dt + i) * M + b * SEQ + (rs + kr) * GW + c0k + 4 * g;
            const f16x4 v0 = *(const f16x4*)vp, v1 = *(const f16x4*)(vp + 16);
            f16x8 vf;
#pragma unroll
            for (int e = 0; e < 4; ++e) { vf[e] = v0[e]; vf[4 + e] = v1[e]; }
            o[dt] = __builtin_amdgcn_mfma_f32_16x16x32_f16(vf, pf, o[dt], 0, 0, 0);
        }
    }
    const float inv = 1.0f / sum;
    f16* op = ATT + (size_t)(b * SEQ + r * GW + qc) * DA + h * HD + 4 * g;
#pragma unroll
    for (int dt = 0; dt < 4; ++dt) { u32x2 w; w.x = pk_f16(o[dt][0] * inv, o[dt][1] * inv); w.y = pk_f16(o[dt][2] * inv, o[dt][3] * inv); *(u32x2*)(op + 16 * dt) = w; }
}

struct Args { const float* in[22]; float* out; unsigned char* ws; };

__global__ void __launch_bounds__(NTHREADS, 2) mk_fwd(Args args) {
    extern __shared__ __attribute__((aligned(16))) unsigned char lds_raw[];
    LAS unsigned char* lds = (LAS unsigned char*)lds_raw;
    volatile LAS unsigned* MISC = (volatile LAS unsigned*)(lds + MISC_OFF);
    const int tid0 = threadIdx.x, lane0 = tid0 & 63, wave = __builtin_amdgcn_readfirstlane(tid0 >> 6);
    const int G = gridDim.x, bx = blockIdx.x;
    const int vcu = (G % 8 == 0) ? (bx % 8) * (G / 8) + bx / 8 : bx;
    const int gw = vcu * NWAVES + wave, NGW = G * NWAVES;
    const int gt0 = vcu * NTHREADS + tid0, NGT = G * NTHREADS;
    unsigned char* ws = args.ws; float* out = args.out;
    for (int u = tid0; u < (LDS_BYTES - LDSCTL_OFF) / 4; u += NTHREADS) ((LAS unsigned*)(lds + LDSCTL_OFF))[u] = 0u;
    __syncthreads();
    XcdBarrier bar = xcd_barrier_post((unsigned*)(ws + WS_CTL) + CW_BAR, MISC + 8);
#define GRID_BAR() xcd_barrier(bar)

    f16* H16 = (f16*)(ws + WS_H16);
    constexpr int NSTEPS = 1 + 10 * DEPTH;
    for (int step = 0; step < NSTEPS; ++step) {
        const int layer = step == 0 ? 0 : (step - 1) / 10, st = step == 0 ? -1 : (step - 1) % 10;
        int lane = lane0, tid = tid0, gt = gt0; asm volatile("" : "+v"(lane), "+v"(tid), "+v"(gt));
        if (st == 1 || st == 3 || st == 4 || st == 6 || st == 8) {
            const int ph = st == 1 ? PH_A : (st == 3 ? PH_C : (st == 4 ? PH_D : (st == 6 ? PH_E : PH_F)));
            const Epi E{ws, out, args.in[5] + (size_t)layer * NPROJ};
            const Sched S{ph, bx, G, ws};
            pg8::gemm_phase(lds, S, E);
        } else if (st == -1 || st == 5 || st == 9) {
            const float* src = st == -1 ? args.in[0] : out;
            const float* g = st == -1 ? args.in[2] : (st == 5 ? args.in[12] : args.in[20]) + (size_t)layer * DM;
            const float* b = st == -1 ? args.in[3] : (st == 5 ? args.in[13] : args.in[21]) + (size_t)layer * DM;
            for (int m = gw; m < M; m += NGW) ln_row(src + (size_t)m * DM, g, b, out + (size_t)m * DM, H16 + (size_t)m * DM, lane);
        } else if (st == 0) {
            LAS float* scr = (LAS float*)(lds + wave * 16384);
            constexpr int I_IN = 16 * 128, I_A = 8 * 32, I_MIX = 16 * 32, I_UP = 16 * 176, I_D = 44 * 32, I_G = 16 * 32, I_P = 4 * 32;
            constexpr int NITEMS = I_IN + I_A + I_MIX + I_UP + I_D + I_G + I_P;
            for (int it = gw; it < NITEMS; it += NGW) {
                int r = it;
                if (r < I_IN) { transpose_item(args.in[4] + (size_t)layer * DM * NPROJ, NPROJ, DM, 128, (f16*)(ws + W_IN), scr, r, lane); continue; } r -= I_IN;
                if (r < I_A) { transpose_item(args.in[7] + (size_t)layer * DA * DM, DM, DA, 32, (f16*)(ws + W_A), scr, r, lane); continue; } r -= I_A;
                if (r < I_MIX) { transpose_item(args.in[11] + (size_t)layer * DM * DM, DM, DM, 32, (f16*)(ws + W_MIX), scr, r, lane); continue; } r -= I_MIX;
                if (r < I_UP) { transpose_item(args.in[14] + (size_t)layer * DM * 2 * DFF, 2 * DFF, DM, 176, (f16*)(ws + W_UP), scr, r, lane); continue; } r -= I_UP;
                if (r < I_D) { transpose_item(args.in[17] + (size_t)layer * DFF * DM, DM, DFF, 32, (f16*)(ws + W_D), scr, r, lane); continue; } r -= I_D;
                if (r < I_G) { transpose_item(args.in[18] + (size_t)layer * DM * DM, DM, DM, 32, (f16*)(ws + W_G), scr, r, lane); continue; } r -= I_G;
                transpose_item(args.in[19] + (size_t)layer * PLE * DM, DM, PLE, 32, (f16*)(ws + W_P), scr, r, lane);
            }
            const float* pw = args.in[8] + (size_t)layer * 4 * 128 * 128; const float* psc = args.in[9] + (size_t)layer * DP; const float* wpo = args.in[10] + (size_t)layer * DP * DM;
            for (int it = gw; it < 64 * 16; it += NGW) {
                const int kb = it >> 4, nb = it & 15, k0 = kb * 8, g = k0 >> 7, c0 = k0 & 127, n = nb * 64 + lane;
                float a8[8];
#pragma unroll
                for (int j = 0; j < 8; ++j) a8[j] = 0.f;
                for (int d = 0; d < 128; ++d) { const float wv = wpo[(size_t)(g * 128 + d) * DM + n] * psc[g * 128 + d];
#pragma unroll
                    for (int j = 0; j < 8; ++j) a8[j] += pw[(size_t)(g * 128 + c0 + j) * 128 + d] * wv; }
                u32x4 o; o.x = pk_f16(a8[0], a8[1]); o.y = pk_f16(a8[2], a8[3]); o.z = pk_f16(a8[4], a8[5]); o.w = pk_f16(a8[6], a8[7]);
                *(u32x4*)((f16*)(ws + W_PC) + (size_t)n * DP + k0) = o;
            }
            const float* pl = args.in[1] + (size_t)layer * M * PLE; f16* P16 = (f16*)(ws + WS_P16);
            for (size_t e = (size_t)gt; e < (size_t)M * PLE / 8; e += NGT) { const f32x4 a = ((const f32x4*)pl)[2 * e], b = ((const f32x4*)pl)[2 * e + 1]; ((u32x4*)P16)[e] = pk8(a, b); }
        } else if (st == 2) {
            LAS float* bias = (LAS float*)lds;
            const float* rp = args.in[6] + (size_t)layer * NH * 15 * 31;
            for (int e = tid; e < NH * 15 * 31; e += NTHREADS) bias[e] = rp[e];
            __syncthreads();
            const f16* Q = (const f16*)(ws + B_Q); const f16* Kb = (const f16*)(ws + B_K); const f16* VT = (const f16*)(ws + B_VT); f16* ATT = (f16*)(ws + B_ATT);
            for (int bu = vcu; bu < NB * ROWS * 4; bu += G) {
                const int b = bu >> 7, r = (bu & 127) >> 2, hp = bu & 3;
                attn_wave_unit(Q, Kb, VT, ATT, bias, b, r, hp * 2 + (wave >> 2), wave & 3, lane);
            }
            const f16* U = (const f16*)(ws + B_U); f16* PD = (f16*)(ws + B_PD);
            for (int it = gt; it < M * 64; it += NGT) {
                const int t = it >> 6, ch = it & 63, grp = ch >> 4, half = 1 << grp, s = t & (SEQ - 1);
                const int lo = max(s - half, 0), hi = min(s + half, SEQ);
                float a8[8];
#pragma unroll
                for (int j = 0; j < 8; ++j) a8[j] = 0.f;
                const f16* up = U + (size_t)(t - s) * DP + ch * 8;
                for (int s2 = lo; s2 < hi; ++s2) { const f16x8 v = *(const f16x8*)(up + (size_t)s2 * DP);
#pragma unroll
                    for (int j = 0; j < 8; ++j) a8[j] += (float)v[j]; }
                const f16x8 self = *(const f16x8*)(up + (size_t)s * DP); const float rc = 1.0f / (float)(hi - lo);
                u32x4 o; o.x = pk_f16(a8[0] * rc - (float)self[0], a8[1] * rc - (float)self[1]); o.y = pk_f16(a8[2] * rc - (float)self[2], a8[3] * rc - (float)self[3]);
                o.z = pk_f16(a8[4] * rc - (float)self[4], a8[5] * rc - (float)self[5]); o.w = pk_f16(a8[6] * rc - (float)self[6], a8[7] * rc - (float)self[7]);
                *(u32x4*)(PD + (size_t)t * DP + ch * 8) = o;
            }
            __syncthreads();
        } else {
            f16* VAL = (f16*)(ws + B_VAL); const f16* GATE = (const f16*)(ws + B_GATE);
            const float* cw = args.in[15] + (size_t)layer * 3 * DFF; const float* cb = args.in[16] + (size_t)layer * DFF;
            constexpr int NCH = DFF / 8;
            for (int it = gt; it < M * NCH; it += NGT) {
                const int t = it / NCH, fc = it - t * NCH, f0 = fc * 8, s = t & (SEQ - 1);
                const f16* gp = GATE + (size_t)t * DFF + f0;
                const f16x8 g1 = *(const f16x8*)gp; f16x8 g0, g2;
#pragma unroll
                for (int j = 0; j < 8; ++j) { g0[j] = (f16)0.f; g2[j] = (f16)0.f; }
                if (s > 0) g0 = *(const f16x8*)(gp - DFF);
                if (s < SEQ - 1) g2 = *(const f16x8*)(gp + DFF);
                const f16x8 vv = *(const f16x8*)(VAL + (size_t)t * DFF + f0);
                float r8[8];
#pragma unroll
                for (int j = 0; j < 8; ++j) { const float y = (float)g0[j] * cw[f0 + j] + (float)g1[j] * cw[DFF + f0 + j] + (float)g2[j] * cw[2 * DFF + f0 + j] + cb[f0 + j];
                    r8[j] = 0.5f * y * (1.0f + erff(y * 0.70710678118654752f)) * (float)vv[j]; }
                u32x4 o; o.x = pk_f16(r8[0], r8[1]); o.y = pk_f16(r8[2], r8[3]); o.z = pk_f16(r8[4], r8[5]); o.w = pk_f16(r8[6], r8[7]);
                *(u32x4*)(VAL + (size_t)t * DFF + f0) = o;
            }
        }
        if (step + 1 < NSTEPS) GRID_BAR();
    }
}

extern "C" void kernel_launch(void* const* d_in, const int* in_sizes, int n_in, void* d_out, int out_size, void* d_ws, size_t ws_size, hipStream_t stream) {
    static int grid = 0;
    if (grid == 0) {
        if (n_in != 22 || out_size != M * DM || ws_size < WS_END) { fprintf(stderr, "kernel_launch: unexpected problem (n_in %d, out %d, ws %zu)\n", n_in, out_size, ws_size); grid = -1; return; }
        { const int exp_sizes[22] = {M * DM, DEPTH * M * PLE, DM, DM, DEPTH * DM * NPROJ, DEPTH * NPROJ, DEPTH * NH * 15 * 31, DEPTH * DA * DM, DEPTH * 4 * 128 * 128, DEPTH * DP, DEPTH * DP * DM, DEPTH * DM * DM,
              DEPTH * DM, DEPTH * DM, DEPTH * DM * 2 * DFF, DEPTH * 3 * DFF, DEPTH * DFF, DEPTH * DFF * DM, DEPTH * DM * DM, DEPTH * PLE * DM, DEPTH * DM, DEPTH * DM};
          for (int i = 0; i < 22; ++i) if (in_sizes[i] != exp_sizes[i]) { fprintf(stderr, "kernel_launch: input %d has %d elements, expected %d\n", i, in_sizes[i], exp_sizes[i]); grid = -1; return; } }
        int dev = 0, cus = 0;
        if (hipGetDevice(&dev) != hipSuccess || hipDeviceGetAttribute(&cus, hipDeviceAttributeMultiprocessorCount, dev) != hipSuccess) { grid = -1; return; }
        if (hipFuncSetAttribute((const void*)mk_fwd, hipFuncAttributeMaxDynamicSharedMemorySize, LDS_BYTES) != hipSuccess) { fprintf(stderr, "kernel_launch: hipFuncSetAttribute failed\n"); grid = -1; return; }
        int per_cu = 0;
        if (hipOccupancyMaxActiveBlocksPerMultiprocessor(&per_cu, (const void*)mk_fwd, NTHREADS, LDS_BYTES) != hipSuccess || per_cu < 1) fprintf(stderr, "kernel_launch: occupancy query reports %d\n", per_cu);
        (void)hipGetLastError();
        grid = cus;
    }
    if (grid < 0) return;
    if (hipMemsetAsync((char*)d_ws + WS_CTL, 0, CTL_ZERO_BYTES, stream) != hipSuccess) return;
    Args a{};
    for (int i = 0; i < 22; ++i) a.in[i] = (const float*)d_in[i];
    a.out = (float*)d_out; a.ws = (unsigned char*)d_ws;
    hipLaunchKernelGGL(mk_fwd, dim3(grid), dim3(NTHREADS), LDS_BYTES, stream, a);
}
```

```cpp
#include <hip/hip_runtime.h>
#include <cstdio>
#include <cstdint>

#define LAS __attribute__((address_space(3)))
typedef _Float16 f16;
typedef _Float16 f16x8 __attribute__((ext_vector_type(8)));
typedef _Float16 f16x4 __attribute__((ext_vector_type(4)));
typedef _Float16 f16x2 __attribute__((ext_vector_type(2)));
typedef float f32x4 __attribute__((ext_vector_type(4)));
typedef float f32x2 __attribute__((ext_vector_type(2)));
typedef unsigned u32x4 __attribute__((ext_vector_type(4)));
typedef unsigned u32x2 __attribute__((ext_vector_type(2)));

constexpr int DM = 1024, NB = 8, SEQ = 2048, M = NB * SEQ, DEPTH = 4, NH = 8, HD = 64, DA = 512, DP = 512, DFF = 2816, PLE = 256, NPROJ = 4096;
constexpr int GW = 64, ROWS = SEQ / GW;
constexpr float ALPHA = 1.681792830507429f;
constexpr float LN_EPS = 1e-5f;
constexpr int NWAVES = 8, NTHREADS = 512;

constexpr size_t MiB = 1u << 20;
constexpr size_t WS_CTL = 0, CTL_ZERO_BYTES = 1 * MiB;
constexpr size_t WS_W = 4 * MiB;
constexpr size_t W_IN = WS_W, W_A = WS_W + 8 * MiB, W_PC = WS_W + 9 * MiB, W_MIX = WS_W + 10 * MiB, W_UP = WS_W + 12 * MiB, W_D = WS_W + 23 * MiB, W_G = WS_W + 29 * MiB, W_P = WS_W + 31 * MiB;
constexpr size_t WS_H16 = 36 * MiB, WS_P16 = 68 * MiB, WS_PLE = 76 * MiB, WS_BIG = 108 * MiB;
constexpr size_t B_Q = WS_BIG, B_K = WS_BIG + 16 * MiB, B_U = WS_BIG + 32 * MiB, B_VT = WS_BIG + 48 * MiB, B_SG = WS_BIG + 64 * MiB, B_ATT = WS_BIG + 128 * MiB, B_PD = WS_BIG + 144 * MiB, B_MRG = WS_BIG + 160 * MiB;
constexpr size_t B_VAL = WS_BIG, B_GATE = WS_BIG + 88 * MiB;
constexpr size_t WS_Z = 300 * MiB;
constexpr size_t WS_END = 364 * MiB;
constexpr int CW_BAR = 4096;

constexpr int RING_BYTES = 131072, LDSCTL_OFF = RING_BYTES, MISC_OFF = LDSCTL_OFF + 320, LDS_BYTES = 147456;

#define VM_WAIT() asm volatile("s_waitcnt vmcnt(0)" ::: "memory")
#define LDS_WAIT() asm volatile("s_waitcnt lgkmcnt(0)" ::: "memory")

#define XB_TMO      128
#define XB_XCNT(j)  (256  + 64 * (j))
#define XB_XSUB(j)  (1280 + 64 * (j))
#define XB_XGEN(j)  (2304 + 64 * (j))
#define XB_TOP      3328
#define XB_TOPGEN   3392
#define XCD_BAR_WORDS 3456
#define XB_SPIN_CAP (1u << 20)
__device__ __forceinline__ unsigned xb_ld(unsigned* p)              { return __hip_atomic_load(p, __ATOMIC_RELAXED, __HIP_MEMORY_SCOPE_AGENT); }
__device__ __forceinline__ unsigned xb_add(unsigned* p, unsigned v) { return __hip_atomic_fetch_add(p, v, __ATOMIC_RELAXED, __HIP_MEMORY_SCOPE_AGENT); }
__device__ __forceinline__ unsigned xb_xcc_id() { return (unsigned)__builtin_amdgcn_s_getreg((3 << 11) | 20) & 0xFu; }
#define XB_SPIN(cond, bar) do { unsigned _sp = 0; while (cond) { __builtin_amdgcn_s_sleep(1); \
    if ((++_sp & 255u) == 0u) { if (xb_ld(&(bar)[XB_TMO])) break; if (_sp > XB_SPIN_CAP) { atomicAdd(&(bar)[XB_TMO], 1u); break; } } } } while (0)
struct XcdBarrier { unsigned* bar; unsigned x; volatile LAS unsigned* st; };
__device__ __forceinline__ XcdBarrier xcd_barrier_post(unsigned* bar, volatile LAS unsigned* st) {
    XcdBarrier b; b.bar = bar; b.x = xb_xcc_id(); b.st = st;
    if (threadIdx.x == 0) (void)xb_add(&bar[XB_XCNT(b.x)], 1u);
    return b;
}
__device__ __forceinline__ void xcd_barrier_complete(unsigned* bar, unsigned x, unsigned& nloc, unsigned& nx) {
    const unsigned G = gridDim.x * gridDim.y * gridDim.z;
    unsigned sum, cnt, mine, sp = 0u;
    for (;;) {
        sum = 0u; cnt = 0u; mine = 0u;
#pragma unroll
        for (unsigned j = 0; j < 16; ++j) { const unsigned c = xb_ld(&bar[XB_XCNT(j)]); sum += c; cnt += (c > 0u) ? 1u : 0u; mine = (j == x) ? c : mine; }
        if (sum == G) break;
        __builtin_amdgcn_s_sleep(1);
        if ((++sp & 255u) == 0u) { if (xb_ld(&bar[XB_TMO])) break; if (sp > XB_SPIN_CAP) { atomicAdd(&bar[XB_TMO], 1u); break; } }
    }
    nloc = mine > 0u ? mine : 1u; nx = cnt > 0u ? cnt : 1u;
}
__device__ __forceinline__ void xcd_barrier(const XcdBarrier& b) {
    asm volatile("s_waitcnt vmcnt(0)" ::: "memory");
    __syncthreads();
    if (threadIdx.x == 0) {
        unsigned* bar = b.bar;
        __builtin_amdgcn_s_waitcnt(0);
        unsigned nloc = b.st[0], nx = b.st[1];
        if (nloc == 0u) { xcd_barrier_complete(bar, b.x, nloc, nx); b.st[0] = nloc; b.st[1] = nx; }
        const unsigned old = xb_add(&bar[XB_XSUB(b.x)], 1u);
        const unsigned gen = old / nloc;
        if (old + 1u == (gen + 1u) * nloc) {
            __builtin_amdgcn_fence(__ATOMIC_RELEASE, "agent");
            asm volatile("s_waitcnt vmcnt(0)" ::: "memory");
            const unsigned og = xb_add(&bar[XB_TOP], 1u);
            const unsigned tg = og / nx;
            if (og + 1u == (tg + 1u) * nx) xb_add(&bar[XB_TOPGEN], 1u);
            else XB_SPIN(xb_ld(&bar[XB_TOPGEN]) == tg, bar);
            __builtin_amdgcn_fence(__ATOMIC_ACQUIRE, "agent");
            xb_add(&bar[XB_XGEN(b.x)], 1u);
            asm volatile("s_waitcnt vmcnt(0)" ::: "memory");
        } else {
            XB_SPIN(xb_ld(&bar[XB_XGEN(b.x)]) == gen, bar);
            __builtin_amdgcn_fence(__ATOMIC_ACQUIRE, "agent");
            asm volatile("s_waitcnt vmcnt(0)" ::: "memory");
        }
    }
    __syncthreads();
}

namespace pg8 {
constexpr int BM = 256, BK = 64, HALF = 128, HTB = HALF * BK * 2, NXCD = 8, WGM = 8;
__host__ __device__ __forceinline__ int lds_byte(int r, int c) { const int st = (r >> 4) * 2 + (c >> 5), rr = r & 15, cc = c & 31, ob = rr * 64 + cc * 2; return st * 1024 + (ob ^ (((ob >> 9) & 1) << 5)); }
__host__ __device__ __forceinline__ void stage_rc(int b, int& R, int& C) { const int st = b / 1024, sb = b % 1024, swz = sb ^ (((sb >> 9) & 1) << 5); R = (st >> 1) * 16 + swz / 64; C = (st & 1) * 32 + (swz % 64) / 2; }
__host__ __device__ __forceinline__ int perm32(int rho) { const int n = rho >> 4, i = rho & 15; return 8 * (i >> 2) + 4 * n + (i & 3); }

__device__ __forceinline__ void tile_order(int nM, int nN, int L, int& pm, int& pn) {
    const int nwg = nM * nN; int wgid = L;
    { const int q = nwg / NXCD, r = nwg % NXCD, xcd = wgid % NXCD, off = wgid / NXCD; wgid = (xcd < r ? xcd * (q + 1) : r * (q + 1) + (xcd - r) * q) + off; }
    const int nig = WGM * nN, gid = wgid / nig, fm = gid * WGM, gsz = (nM - fm) < WGM ? (nM - fm) : WGM;
    pm = fm + ((wgid % nig) % gsz); pn = (wgid % nig) / gsz;
}

struct GUnit { const char* A; const char* B; int K; int kind; int pm; int pn; };

template <class Sched, class Epi>
__device__ __forceinline__ void gemm_phase(LAS unsigned char* lds, const Sched& S, const Epi& E) {
    const int tid = threadIdx.x, wid = __builtin_amdgcn_readfirstlane(tid >> 6), lane = tid & 63, wr = wid >> 2, wc = wid & 3, fr = lane & 15, fq = lane >> 4;
    int R0, C0; stage_rc(tid * 16, R0, C0);
    const unsigned ra = (unsigned)R0, rb = (unsigned)((R0 & ~31) + perm32(R0 & 31)), c2 = (unsigned)C0 * 2u;
    const size_t kstep = (size_t)(BK * 2);
    const unsigned ldsw = (unsigned)wid * 1024u;
    const int aoff = lds_byte(wr * 64 + fr, fq * 8), boff = lds_byte(wc * 32 + fr, fq * 8);
#define PG8_SA(b, h) (((b) * 2 + (h)) * HTB)
#define PG8_SB(b, h) ((4 + (b) * 2 + (h)) * HTB)
#define PG8_STAGE(bufoff, gbase, voff, h64) do { \
        __builtin_amdgcn_global_load_lds((const unsigned*)((const char*)(gbase) + (voff)), (LAS unsigned*)(lds + (bufoff) + ldsw), 16, 0, 0); \
        __builtin_amdgcn_global_load_lds((const unsigned*)((const char*)(gbase) + (h64) + (voff)), (LAS unsigned*)(lds + (bufoff) + ldsw + 8192), 16, 0, 0); } while (0)
#define PG8_LDA(dst, b, h) do { _Pragma("unroll") for (int m = 0; m < 4; ++m) _Pragma("unroll") for (int k = 0; k < 2; ++k) dst[m][k] = *(const LAS f16x8*)(lds + PG8_SA(b, h) + aoff + m * 2048 + k * 1024); } while (0)
#define PG8_LDB(dst, b, h) do { _Pragma("unroll") for (int n = 0; n < 2; ++n) _Pragma("unroll") for (int k = 0; k < 2; ++k) dst[n][k] = *(const LAS f16x8*)(lds + PG8_SB(b, h) + boff + n * 2048 + k * 1024); } while (0)
#define PG8_MMA(ai, bj, At, Bt) do { __builtin_amdgcn_s_setprio(1); _Pragma("unroll") for (int m = 0; m < 4; ++m) _Pragma("unroll") for (int n = 0; n < 2; ++n) _Pragma("unroll") for (int k = 0; k < 2; ++k) \
        acc[ai][bj][m][n] = __builtin_amdgcn_mfma_f32_16x16x32_f16(Bt[n][k], At[m][k], acc[ai][bj][m][n], 0, 0, 0); __builtin_amdgcn_s_setprio(0); } while (0)
#define PG8_WAIT_V(n) asm volatile("s_waitcnt vmcnt(" #n ")" ::: "memory")
#define PG8_WAIT_L(n) asm volatile("s_waitcnt lgkmcnt(" #n ")" ::: "memory")
#define PG8_BAR __builtin_amdgcn_s_barrier()
#define PG8_SCHED __builtin_amdgcn_sched_barrier(0)
    GUnit cur, nxt; int ui = 0;
    if (!S.next(0, cur)) return;
    f32x4 acc[2][2][4][2];
#pragma unroll
    for (int a = 0; a < 2; ++a)
#pragma unroll
        for (int b = 0; b < 2; ++b)
#pragma unroll
            for (int m = 0; m < 4; ++m)
#pragma unroll
                for (int n = 0; n < 2; ++n) acc[a][b][m][n] = (f32x4){0.f, 0.f, 0.f, 0.f};
    f16x8 At[4][2], B0[2][2], B1[2][2];
    const char* cA = cur.A; const char* cB = cur.B;
    unsigned cK2 = (unsigned)cur.K * 2u;
    unsigned cvA = ra * cK2 + c2, cvB = rb * cK2 + c2;
    size_t ch64 = (size_t)64 * cK2, chs = (size_t)128 * cK2;
    PG8_STAGE(PG8_SB(0, 0), cB, cvB, ch64); PG8_STAGE(PG8_SB(0, 1), cB + chs, cvB, ch64); PG8_STAGE(PG8_SA(0, 0), cA, cvA, ch64); PG8_STAGE(PG8_SA(0, 1), cA + chs, cvA, ch64);
    if (wr == 1) PG8_BAR;
    PG8_WAIT_V(2); PG8_BAR;
    PG8_STAGE(PG8_SB(1, 0), cB + kstep, cvB, ch64); PG8_STAGE(PG8_SA(1, 0), cA + kstep, cvA, ch64); PG8_STAGE(PG8_SB(1, 1), cB + chs + kstep, cvB, ch64);
    PG8_WAIT_V(6); PG8_BAR;
    for (;;) {
        const bool has_next = S.next(ui + 1, nxt);
        const char* nA = has_next ? nxt.A : cA; const char* nB = has_next ? nxt.B : cB;
        const unsigned nK2 = has_next ? (unsigned)nxt.K * 2u : cK2;
        const unsigned nvA = ra * nK2 + c2, nvB = rb * nK2 + c2;
        const size_t nh64 = (size_t)64 * nK2, nhs = (size_t)128 * nK2;
        const int nt = (int)(cK2 >> 7);
        for (int t = 0; t < nt; t += 2) {
            const bool last = (t == nt - 2);
            const char* a1 = cA + (size_t)(t + 1) * kstep;
            const char* a2 = last ? nA : cA + (size_t)(t + 2) * kstep; const char* b2 = last ? nB : cB + (size_t)(t + 2) * kstep;
            const char* a3 = a2 + kstep; const char* b3 = b2 + kstep;
            const unsigned vA2 = last ? nvA : cvA, vB2 = last ? nvB : cvB;
            const size_t h2 = last ? nh64 : ch64, hs2 = last ? nhs : chs;
            PG8_LDB(B0, 0, 0); PG8_LDB(B1, 0, 1); PG8_SCHED; PG8_LDA(At, 0, 0); PG8_STAGE(PG8_SA(1, 1), a1 + chs, cvA, ch64);
            PG8_WAIT_V(8); PG8_WAIT_L(0); PG8_BAR; PG8_MMA(0, 0, At, B0); PG8_MMA(0, 1, At, B1); PG8_BAR; PG8_SCHED;
            PG8_LDA(At, 0, 1); PG8_STAGE(PG8_SB(0, 0), b2, vB2, h2); PG8_STAGE(PG8_SB(0, 1), b2 + hs2, vB2, h2); PG8_STAGE(PG8_SA(0, 0), a2, vA2, h2);
            PG8_WAIT_V(8); PG8_WAIT_L(0); PG8_BAR; PG8_MMA(1, 0, At, B0); PG8_MMA(1, 1, At, B1); PG8_BAR; PG8_SCHED;
            PG8_LDB(B0, 1, 0); PG8_LDB(B1, 1, 1); PG8_SCHED; PG8_LDA(At, 1, 0); PG8_STAGE(PG8_SA(0, 1), a2 + hs2, vA2, h2);
            PG8_WAIT_V(8); PG8_WAIT_L(0); PG8_BAR; PG8_MMA(0, 0, At, B0); PG8_MMA(0, 1, At, B1); PG8_BAR; PG8_SCHED;
            PG8_LDA(At, 1, 1); PG8_STAGE(PG8_SB(1, 0), b3, vB2, h2); PG8_STAGE(PG8_SB(1, 1), b3 + hs2, vB2, h2); PG8_STAGE(PG8_SA(1, 0), a3, vA2, h2);
            PG8_WAIT_V(8); PG8_WAIT_L(0); PG8_BAR; PG8_MMA(1, 0, At, B0); PG8_MMA(1, 1, At, B1); PG8_BAR; PG8_SCHED;
        }
        if (wr == 0) PG8_BAR;
        E(acc, cur, wr, wc, fr, fq);
        if (!has_next) break;
#pragma unroll
        for (int a = 0; a < 2; ++a)
#pragma unroll
            for (int b = 0; b < 2; ++b)
#pragma unroll
                for (int m = 0; m < 4; ++m)
#pragma unroll
                    for (int n = 0; n < 2; ++n) acc[a][b][m][n] = (f32x4){0.f, 0.f, 0.f, 0.f};
        cur = nxt; cA = nA; cB = nB; cK2 = nK2; cvA = nvA; cvB = nvB; ch64 = nh64; chs = nhs; ++ui;
        if (wr == 1) PG8_BAR;
    }
    PG8_WAIT_V(0);
    PG8_BAR;
#undef PG8_SA
#undef PG8_SB
#undef PG8_STAGE
#undef PG8_LDA
#undef PG8_LDB
#undef PG8_MMA
#undef PG8_WAIT_V
#undef PG8_WAIT_L
#undef PG8_BAR
#undef PG8_SCHED
}
}
using pg8::GUnit;

enum Kind { K_Q = 0, K_K, K_U, K_SG, K_VT, K_Y1, K_Y2, K_MIX, K_VAL, K_GATE, K_PP, K_PG, K_DOWN };

__device__ __forceinline__ unsigned pk_f16(float lo, float hi) { f16x2 h = {(f16)lo, (f16)hi}; return __builtin_bit_cast(unsigned, h); }
__device__ __forceinline__ u32x4 pk8(const f32x4 v0, const f32x4 v1) { u32x4 w; w.x = pk_f16(v0[0], v0[1]); w.y = pk_f16(v0[2], v0[3]); w.z = pk_f16(v1[0], v1[1]); w.w = pk_f16(v1[2], v1[3]); return w; }
__device__ __forceinline__ void unpk8(const u32x4 w, f32x4& v0, f32x4& v1) {
    const f16x8 h = __builtin_bit_cast(f16x8, w);
    v0 = (f32x4){(float)h[0], (float)h[1], (float)h[2], (float)h[3]}; v1 = (f32x4){(float)h[4], (float)h[5], (float)h[6], (float)h[7]};
}
__device__ __forceinline__ f32x2 gelu_pk(f32x2 v) {
    const f32x2 av = __builtin_elementwise_abs(v), d = av * 0.2316418882f + 1.0f;
    f32x2 t; t.x = __builtin_amdgcn_rcpf(d.x); t.y = __builtin_amdgcn_rcpf(d.y);
    f32x2 q = t * 0.5307027145f + (-0.7265760135f); q = q * t + 0.7107068705f; q = q * t + (-0.142248368f); q = q * t + 0.127414796f; q = q * t;
    const f32x2 s = (v * v) * (-0.72134752044f);
    f32x2 e; e.x = __builtin_amdgcn_exp2f(s.x); e.y = __builtin_amdgcn_exp2f(s.y);
    const f32x2 m = v * (q * e), r = v - m;
    f32x2 o; o.x = v.x < 0.f ? m.x : r.x; o.y = v.y < 0.f ? m.y : r.y; return o;
}
__device__ __forceinline__ float sigmoidf_(float x) { return __builtin_amdgcn_rcpf(1.0f + __expf(-x)); }
__device__ __forceinline__ f32x4 sig4(const f32x4 v) { return (f32x4){sigmoidf_(v[0]), sigmoidf_(v[1]), sigmoidf_(v[2]), sigmoidf_(v[3])}; }

struct Epi {
    unsigned char* ws; float* out; const float* b_in;
    __device__ __forceinline__ void operator()(const f32x4 (&acc)[2][2][4][2], const GUnit& u, int wr, int wc, int fr, int fq) const {
        const int kind = u.kind;
        const int rl0 = wr * 64 + fr, cl0 = wc * 32 + 8 * fq;
        const int grow0 = u.pm * 256 + rl0, gcol0 = u.pn * 256 + cl0;
        if (kind <= K_SG) {
            f16* base; int ldc, col0; const float* bias = b_in + gcol0;
            if (kind == K_Q)      { base = (f16*)(ws + B_Q); ldc = 512; col0 = gcol0; }
            else if (kind == K_K) { base = (f16*)(ws + B_K); ldc = 512; col0 = gcol0 - 512; }
            else if (kind == K_U) { base = (f16*)(ws + B_U); ldc = 512; col0 = gcol0 - 1536; }
            else                  { base = (f16*)(ws + B_SG); ldc = 2048; col0 = gcol0 - 2048; }
            f32x4 bv[2][2];
#pragma unroll
            for (int bj = 0; bj < 2; ++bj)
#pragma unroll
                for (int n = 0; n < 2; ++n) bv[bj][n] = *(const f32x4*)(bias + bj * 128 + 4 * n);
#pragma unroll
            for (int ai = 0; ai < 2; ++ai)
#pragma unroll
                for (int m = 0; m < 4; ++m) { f16* rowp = base + (size_t)(grow0 + ai * 128 + m * 16) * ldc + col0;
#pragma unroll
                    for (int bj = 0; bj < 2; ++bj) { f32x4 v0 = acc[ai][bj][m][0] + bv[bj][0], v1 = acc[ai][bj][m][1] + bv[bj][1];
                        if (kind == K_SG) { v0 = sig4(v0); v1 = sig4(v1); }
                        *(u32x4*)(rowp + bj * 128) = pk8(v0, v1); } }
        } else if (kind == K_VT) {
            f16* base = (f16*)(ws + B_VT);
#pragma unroll
            for (int ai = 0; ai < 2; ++ai)
#pragma unroll
                for (int m = 0; m < 4; ++m) { const int row = grow0 + ai * 128 + m * 16; const float bz = b_in[1024 + row]; f16* rowp = base + (size_t)row * M + gcol0;
#pragma unroll
                    for (int bj = 0; bj < 2; ++bj) *(u32x4*)(rowp + bj * 128) = pk8(acc[ai][bj][m][0] + bz, acc[ai][bj][m][1] + bz); }
        } else if (kind == K_Y1 || kind == K_Y2) {
            f16* mrg = (f16*)(ws + B_MRG); const f16* sg = (const f16*)(ws + B_SG) + (kind == K_Y2 ? 1024 : 0);
#pragma unroll
            for (int ai = 0; ai < 2; ++ai)
#pragma unroll
                for (int m = 0; m < 4; ++m) { const size_t row = (size_t)(grow0 + ai * 128 + m * 16);
#pragma unroll
                    for (int bj = 0; bj < 2; ++bj) { const int col = gcol0 + bj * 128;
                        f32x4 g0, g1; unpk8(*(const u32x4*)(sg + row * 2048 + col), g0, g1);
                        f32x4 v0 = acc[ai][bj][m][0] * g0, v1 = acc[ai][bj][m][1] * g1;
                        if (kind == K_Y2) { f32x4 p0, p1; unpk8(*(const u32x4*)(mrg + row * 1024 + col), p0, p1); v0 += p0; v1 += p1; }
                        *(u32x4*)(mrg + row * 1024 + col) = pk8(v0, v1); } }
        } else if (kind == K_MIX || kind == K_DOWN) {
            const f16* ple = (const f16*)(ws + WS_PLE);
#pragma unroll
            for (int ai = 0; ai < 2; ++ai)
#pragma unroll
                for (int m = 0; m < 4; ++m) { const size_t row = (size_t)(grow0 + ai * 128 + m * 16);
#pragma unroll
                    for (int bj = 0; bj < 2; ++bj) { const int col = gcol0 + bj * 128; const float* hi = out + row * 1024 + col; float* o = (float*)(ws + WS_Z) + row * 1024 + col;
                        f32x4 v0 = acc[ai][bj][m][0] + ALPHA * *(const f32x4*)hi, v1 = acc[ai][bj][m][1] + ALPHA * *(const f32x4*)(hi + 4);
                        if (kind == K_DOWN) { f32x4 p0, p1; unpk8(*(const u32x4*)(ple + row * 1024 + col), p0, p1); v0 += p0; v1 += p1; }
                        *(f32x4*)o = v0; *(f32x4*)(o + 4) = v1; } }
        } else if (kind == K_VAL || kind == K_GATE) {
            f16* base = (f16*)(ws + (kind == K_VAL ? B_VAL : B_GATE)); const int col0 = gcol0 - (kind == K_GATE ? DFF : 0);
#pragma unroll
            for (int ai = 0; ai < 2; ++ai)
#pragma unroll
                for (int m = 0; m < 4; ++m) { f16* rowp = base + (size_t)(grow0 + ai * 128 + m * 16) * DFF + col0;
#pragma unroll
                    for (int bj = 0; bj < 2; ++bj) *(u32x4*)(rowp + bj * 128) = pk8(acc[ai][bj][m][0], acc[ai][bj][m][1]); }
        } else {
            f16* ple = (f16*)(ws + WS_PLE);
#pragma unroll
            for (int ai = 0; ai < 2; ++ai)
#pragma unroll
                for (int m = 0; m < 4; ++m) { f16* rowp = ple + (size_t)(grow0 + ai * 128 + m * 16) * 1024 + gcol0;
#pragma unroll
                    for (int bj = 0; bj < 2; ++bj) { f32x4 v0 = acc[ai][bj][m][0], v1 = acc[ai][bj][m][1];
                        if (kind == K_PG) { f32x4 p0, p1; unpk8(*(const u32x4*)(rowp + bj * 128), p0, p1); v0 = sig4(v0) * p0; v1 = sig4(v1) * p1; }
                        *(u32x4*)(rowp + bj * 128) = pk8(v0, v1); } }
        }
    }
};

enum Phase { PH_A = 0, PH_C, PH_D, PH_E, PH_F };
struct Sched {
    int phase, c, G; unsigned char* ws;
    __device__ __forceinline__ bool next(int i, GUnit& u) const {
        const char* w = (const char*)ws;
        if (phase == PH_A) {
            const int L = i * G + c; if (L >= 1024) return false;
            if (L < 896) { int pm, j; pg8::tile_order(64, 14, L, pm, j); const int pn = j < 4 ? j : j + 2;
                u.A = w + WS_H16 + (size_t)pm * 256 * 1024 * 2; u.B = w + W_IN + (size_t)pn * 256 * 1024 * 2; u.K = 1024; u.pm = pm; u.pn = pn;
                u.kind = pn < 2 ? K_Q : (pn < 4 ? K_K : (pn < 8 ? K_U : K_SG)); }
            else { int pm, pn; pg8::tile_order(2, 64, L - 896, pm, pn);
                u.A = w + W_IN + (size_t)(1024 + pm * 256) * 1024 * 2; u.B = w + WS_H16 + (size_t)pn * 256 * 1024 * 2; u.K = 1024; u.pm = pm; u.pn = pn; u.kind = K_VT; }
            return true;
        } else if (phase == PH_C) {
            if (i >= 2 || c >= 256) return false;
            int pm, pn; pg8::tile_order(64, 4, c, pm, pn); u.pm = pm; u.pn = pn; u.K = 512;
            if (i == 0) { u.A = w + B_ATT + (size_t)pm * 256 * 512 * 2; u.B = w + W_A + (size_t)pn * 256 * 512 * 2; u.kind = K_Y1; }
            else        { u.A = w + B_PD + (size_t)pm * 256 * 512 * 2; u.B = w + W_PC + (size_t)pn * 256 * 512 * 2; u.kind = K_Y2; }
            return true;
        } else if (phase == PH_D) {
            if (i >= 1 || c >= 256) return false;
            int pm, pn; pg8::tile_order(64, 4, c, pm, pn); u.pm = pm; u.pn = pn; u.K = 1024;
            u.A = w + B_MRG + (size_t)pm * 256 * 1024 * 2; u.B = w + W_MIX + (size_t)pn * 256 * 1024 * 2; u.kind = K_MIX; return true;
        } else if (phase == PH_E) {
            if (i < 2) { if (c >= 256) return false; int pm, pn; pg8::tile_order(64, 4, c, pm, pn); u.pm = pm; u.pn = pn;
                if (i == 0) { u.K = 256; u.A = w + WS_P16 + (size_t)pm * 256 * 256 * 2; u.B = w + W_P + (size_t)pn * 256 * 256 * 2; u.kind = K_PP; }
                else        { u.K = 1024; u.A = w + WS_H16 + (size_t)pm * 256 * 1024 * 2; u.B = w + W_G + (size_t)pn * 256 * 1024 * 2; u.kind = K_PG; }
                return true; }
            const int L = (i - 2) * G + c; if (L >= 1408) return false;
            int pm, pn; pg8::tile_order(64, 22, L, pm, pn); u.pm = pm; u.pn = pn; u.K = 1024;
            u.A = w + WS_H16 + (size_t)pm * 256 * 1024 * 2; u.B = w + W_UP + (size_t)pn * 256 * 1024 * 2; u.kind = pn < 11 ? K_VAL : K_GATE; return true;
        } else {
            if (i >= 1 || c >= 256) return false;
            int pm, pn; pg8::tile_order(64, 4, c, pm, pn); u.pm = pm; u.pn = pn; u.K = DFF;
            u.A = w + B_VAL + (size_t)pm * 256 * DFF * 2; u.B = w + W_D + (size_t)pn * 256 * DFF * 2; u.kind = K_DOWN; return true;
        }
    }
};

__device__ __forceinline__ float wave_sum(float v) {
#pragma unroll
    for (int o = 1; o < 64; o <<= 1) v += __shfl_xor(v, o);
    return v;
}
__device__ __forceinline__ void transpose_item(const float* W, int ldw, int K, int nblk, f16* WT, LAS float* scr, int item, int lane) {
    const int kb = item / nblk, nb = item % nblk, k0 = 64 * kb, n0 = 32 * nb;
#pragma unroll 8
    for (int i = 0; i < 32; ++i) { const int kk = 2 * i + (lane >> 5); scr[kk * 33 + (lane & 31)] = W[(size_t)(k0 + kk) * ldw + n0 + (lane & 31)]; }
    LDS_WAIT(); asm volatile("" ::: "memory");
    const int c = lane & 7;
#pragma unroll
    for (int j = 0; j < 4; ++j) { const int n = (lane >> 3) + 8 * j; const LAS float* s = scr + (8 * c) * 33 + n;
        u32x4 o; o.x = pk_f16(s[0 * 33], s[1 * 33]); o.y = pk_f16(s[2 * 33], s[3 * 33]); o.z = pk_f16(s[4 * 33], s[5 * 33]); o.w = pk_f16(s[6 * 33], s[7 * 33]);
        *(u32x4*)(WT + (size_t)(n0 + n) * K + k0 + 8 * c) = o; }
    LDS_WAIT(); asm volatile("" ::: "memory");
}
__device__ __forceinline__ void ln_row(const float* xrow, const float* g, const float* b, float* orow, f16* hrow, int lane) {
    const f32x4* xr = (const f32x4*)xrow + lane;
    f32x4 v[4]; float s = 0.f;
#pragma unroll
    for (int j = 0; j < 4; ++j) { v[j] = xr[64 * j]; s += (v[j].x + v[j].y) + (v[j].z + v[j].w); }
    const float mean = wave_sum(s) * (1.f / DM); float s2 = 0.f;
#pragma unroll
    for (int j = 0; j < 4; ++j) { v[j] = v[j] - mean; s2 += (v[j].x * v[j].x + v[j].y * v[j].y) + (v[j].z * v[j].z + v[j].w * v[j].w); }
    const float rstd = 1.f / sqrtf(wave_sum(s2) * (1.f / DM) + LN_EPS);
#pragma unroll
    for (int j = 0; j < 4; ++j) { const f32x4 gg = ((const f32x4*)g)[lane + 64 * j], bb = ((const f32x4*)b)[lane + 64 * j]; const f32x4 y = v[j] * rstd * gg + bb;
        ((f32x4*)orow)[lane + 64 * j] = y; u32x2 w; w.x = pk_f16(y.x, y.y); w.y = pk_f16(y.z, y.w); ((u32x2*)hrow)[lane + 64 * j] = w; }
}

__device__ __forceinline__ void attn_wave_unit(const f16* __restrict__ Q, const f16* __restrict__ Kb, const f16* __restrict__ VT, f16* __restrict__ ATT, const LAS float* bias, int b, int r, int h, int qb, int lane) {
    const int i = lane & 15, g = lane >> 4;
    const int c0q = qb * 16, c0k = min(max(c0q - 8, 0), 32), rs = min(max(r - 4, 0), ROWS - 8);
    const int qc = c0q + i, cs = min(max(qc - 8, 0), GW - 16);
    const f16* qp = Q + (size_t)(b * SEQ + r * GW + qc) * DA + h * HD + 8 * g;
    const f16x8 qf0 = *(const f16x8*)qp, qf1 = *(const f16x8*)(qp + 32);
    f32x4 st[8][2];
#pragma unroll
    for (int kr = 0; kr < 8; ++kr) {
        const f16* kp = Kb + (size_t)(b * SEQ + (rs + kr) * GW + c0k + i) * DA + h * HD + 8 * g;
#pragma unroll
        for (int ct = 0; ct < 2; ++ct) {
            const f16x8 k0 = *(const f16x8*)(kp + ct * 16 * DA), k1 = *(const f16x8*)(kp + ct * 16 * DA + 32);
            f32x4 a = (f32x4){0.f, 0.f, 0.f, 0.f};
            a = __builtin_amdgcn_mfma_f32_16x16x32_f16(k0, qf0, a, 0, 0, 0);
            a = __builtin_amdgcn_mfma_f32_16x16x32_f16(k1, qf1, a, 0, 0, 0);
            st[kr][ct] = a;
        }
    }
    float mx = -1e30f;
#pragma unroll
    for (int kr = 0; kr < 8; ++kr) {
        const LAS float* brow = bias + (h * 15 + (rs + kr - r + 7)) * 31;
#pragma unroll
        for (int ct = 0; ct < 2; ++ct)
#pragma unroll
            for (int e = 0; e < 4; ++e) {
                const int kc = c0k + 16 * ct + 4 * g + e; const bool valid = (kc >= cs) && (kc < cs + 16);
                const int co = min(max(kc - qc + 15, 0), 30);
                float s = st[kr][ct][e] * 0.125f + brow[co];
                s = valid ? s : -1e30f; st[kr][ct][e] = s; mx = fmaxf(mx, s);
            }
    }
    mx = fmaxf(mx, __shfl_xor(mx, 16)); mx = fmaxf(mx, __shfl_xor(mx, 32));
    float sum = 0.f;
#pragma unroll
    for (int kr = 0; kr < 8; ++kr)
#pragma unroll
        for (int ct = 0; ct < 2; ++ct)
#pragma unroll
            for (int e = 0; e < 4; ++e) { const float p = __expf(st[kr][ct][e] - mx); st[kr][ct][e] = p; sum += p; }
    sum += __shfl_xor(sum, 16); sum += __shfl_xor(sum, 32);
    f32x4 o[4];
#pragma unroll
    for (int dt = 0; dt < 4; ++dt) o[dt] = (f32x4){0.f, 0.f, 0.f, 0.f};
#pragma unroll
    for (int kr = 0; kr < 8; ++kr) {
        f16x8 pf;
#pragma unroll
        for (int e = 0; e < 4; ++e) { pf[e] = (f16)st[kr][0][e]; pf[4 + e] = (f16)st[kr][1][e]; }
#pragma unroll
        for (int dt = 0; dt < 4; ++dt) {
            const f16* vp = VT + (size_t)(h * HD + 16 * dt + i) * M + b * SEQ + (rs + kr) * GW + c0k + 4 * g;
            const f16x4 v0 = *(const f16x4*)vp, v1 = *(const f16x4*)(vp + 16);
            f16x8 vf;
#pragma unroll
            for (int e = 0; e < 4; ++e) { vf[e] = v0[e]; vf[4 + e] = v1[e]; }
            o[dt] = __builtin_amdgcn_mfma_f32_16x16x32_f16(vf, pf, o[dt], 0, 0, 0);
        }
    }
    const float inv = 1.0f / sum;
    f16* op = ATT + (size_t)(b * SEQ + r * GW + qc) * DA + h * HD + 4 * g;
#pragma unroll
    for (int dt = 0; dt < 4; ++dt) { u32x2 w; w.x = pk_f16(o[dt][0] * inv, o[dt][1] * inv); w.y = pk_f16(o[dt][2] * inv, o[dt][3] * inv); *(u32x2*)(op + 16 * dt) = w; }
}

struct Args { const float* in[22]; float* out; unsigned char* ws; };

__global__ void __launch_bounds__(NTHREADS, 2) mk_fwd(Args args) {
    extern __shared__ __attribute__((aligned(16))) unsigned char lds_raw[];
    LAS unsigned char* lds = (LAS unsigned char*)lds_raw;
    volatile LAS unsigned* MISC = (volatile LAS unsigned*)(lds + MISC_OFF);
    const int tid0 = threadIdx.x, lane0 = tid0 & 63, wave = __builtin_amdgcn_readfirstlane(tid0 >> 6);
    const int G = gridDim.x, bx = blockIdx.x;
    const int vcu = (G % 8 == 0) ? (bx % 8) * (G / 8) + bx / 8 : bx;
    const int gw = vcu * NWAVES + wave, NGW = G * NWAVES;
    const int gt0 = vcu * NTHREADS + tid0, NGT = G * NTHREADS;
    unsigned char* ws = args.ws; float* out = args.out;
    for (int u = tid0; u < (LDS_BYTES - LDSCTL_OFF) / 4; u += NTHREADS) ((LAS unsigned*)(lds + LDSCTL_OFF))[u] = 0u;
    __syncthreads();
    XcdBarrier bar = xcd_barrier_post((unsigned*)(ws + WS_CTL) + CW_BAR, MISC + 8);
#define GRID_BAR() xcd_barrier(bar)

    f16* H16 = (f16*)(ws + WS_H16);
#ifndef REPEAT_ST
#define REPEAT_ST -1
#endif
    constexpr int SPL = 10 + (REPEAT_ST >= 0 ? 1 : 0);
    constexpr int NSTEPS = 1 + SPL * DEPTH;
    for (int step = 0; step < NSTEPS; ++step) {
        const int layer = step == 0 ? 0 : (step - 1) / SPL, sidx = step == 0 ? -1 : (step - 1) % SPL, st = (REPEAT_ST >= 0 && sidx > REPEAT_ST) ? sidx - 1 : sidx;
        int lane = lane0, tid = tid0, gt = gt0; asm volatile("" : "+v"(lane), "+v"(tid), "+v"(gt));
        if (st == 1 || st == 3 || st == 4 || st == 6 || st == 8) {
            const int ph = st == 1 ? PH_A : (st == 3 ? PH_C : (st == 4 ? PH_D : (st == 6 ? PH_E : PH_F)));
            const Epi E{ws, out, args.in[5] + (size_t)layer * NPROJ};
            const Sched S{ph, bx, G, ws};
            pg8::gemm_phase(lds, S, E);
        } else if (st == -1 || st == 5 || st == 9) {
            const float* src = st == -1 ? args.in[0] : (const float*)(ws + WS_Z);
            const float* g = st == -1 ? args.in[2] : (st == 5 ? args.in[12] : args.in[20]) + (size_t)layer * DM;
            const float* b = st == -1 ? args.in[3] : (st == 5 ? args.in[13] : args.in[21]) + (size_t)layer * DM;
            for (int m = gw; m < M; m += NGW) ln_row(src + (size_t)m * DM, g, b, out + (size_t)m * DM, H16 + (size_t)m * DM, lane);
        } else if (st == 0) {
            LAS float* scr = (LAS float*)(lds + wave * 16384);
            constexpr int I_IN = 16 * 128, I_A = 8 * 32, I_MIX = 16 * 32, I_UP = 16 * 176, I_D = 44 * 32, I_G = 16 * 32, I_P = 4 * 32;
            constexpr int NITEMS = I_IN + I_A + I_MIX + I_UP + I_D + I_G + I_P;
            for (int it = gw; it < NITEMS; it += NGW) {
                int r = it;
                if (r < I_IN) { transpose_item(args.in[4] + (size_t)layer * DM * NPROJ, NPROJ, DM, 128, (f16*)(ws + W_IN), scr, r, lane); continue; } r -= I_IN;
                if (r < I_A) { transpose_item(args.in[7] + (size_t)layer * DA * DM, DM, DA, 32, (f16*)(ws + W_A), scr, r, lane); continue; } r -= I_A;
                if (r < I_MIX) { transpose_item(args.in[11] + (size_t)layer * DM * DM, DM, DM, 32, (f16*)(ws + W_MIX), scr, r, lane); continue; } r -= I_MIX;
                if (r < I_UP) { transpose_item(args.in[14] + (size_t)layer * DM * 2 * DFF, 2 * DFF, DM, 176, (f16*)(ws + W_UP), scr, r, lane); continue; } r -= I_UP;
                if (r < I_D) { transpose_item(args.in[17] + (size_t)layer * DFF * DM, DM, DFF, 32, (f16*)(ws + W_D), scr, r, lane); continue; } r -= I_D;
                if (r < I_G) { transpose_item(args.in[18] + (size_t)layer * DM * DM, DM, DM, 32, (f16*)(ws + W_G), scr, r, lane); continue; } r -= I_G;
                transpose_item(args.in[19] + (size_t)layer * PLE * DM, DM, PLE, 32, (f16*)(ws + W_P), scr, r, lane);
            }
            const float* pw = args.in[8] + (size_t)layer * 4 * 128 * 128; const float* psc = args.in[9] + (size_t)layer * DP; const float* wpo = args.in[10] + (size_t)layer * DP * DM;
            for (int it = gw; it < 64 * 16; it += NGW) {
                const int kb = it >> 4, nb = it & 15, k0 = kb * 8, g = k0 >> 7, c0 = k0 & 127, n = nb * 64 + lane;
                float a8[8];
#pragma unroll
                for (int j = 0; j < 8; ++j) a8[j] = 0.f;
                for (int d = 0; d < 128; ++d) { const float wv = wpo[(size_t)(g * 128 + d) * DM + n] * psc[g * 128 + d];
#pragma unroll
                    for (int j = 0; j < 8; ++j) a8[j] += pw[(size_t)(g * 128 + c0 + j) * 128 + d] * wv; }
                u32x4 o; o.x = pk_f16(a8[0], a8[1]); o.y = pk_f16(a8[2], a8[3]); o.z = pk_f16(a8[4], a8[5]); o.w = pk_f16(a8[6], a8[7]);
                *(u32x4*)((f16*)(ws + W_PC) + (size_t)n * DP + k0) = o;
            }
            const float* pl = args.in[1] + (size_t)layer * M * PLE; f16* P16 = (f16*)(ws + WS_P16);
            for (size_t e = (size_t)gt; e < (size_t)M * PLE / 8; e += NGT) { const f32x4 a = ((const f32x4*)pl)[2 * e], b = ((const f32x4*)pl)[2 * e + 1]; ((u32x4*)P16)[e] = pk8(a, b); }
        } else if (st == 2) {
            LAS float* bias = (LAS float*)lds;
            const float* rp = args.in[6] + (size_t)layer * NH * 15 * 31;
            for (int e = tid; e < NH * 15 * 31; e += NTHREADS) bias[e] = rp[e];
            __syncthreads();
            const f16* Q = (const f16*)(ws + B_Q); const f16* Kb = (const f16*)(ws + B_K); const f16* VT = (const f16*)(ws + B_VT); f16* ATT = (f16*)(ws + B_ATT);
            for (int bu = vcu; bu < NB * ROWS * 4; bu += G) {
                const int b = bu >> 7, r = (bu & 127) >> 2, hp = bu & 3;
                attn_wave_unit(Q, Kb, VT, ATT, bias, b, r, hp * 2 + (wave >> 2), wave & 3, lane);
            }
            const f16* U = (const f16*)(ws + B_U); f16* PD = (f16*)(ws + B_PD);
            for (int it = gt; it < M * 64; it += NGT) {
                const int t = it >> 6, ch = it & 63, grp = ch >> 4, half = 1 << grp, s = t & (SEQ - 1);
                const int lo = max(s - half, 0), hi = min(s + half, SEQ);
                float a8[8];
#pragma unroll
                for (int j = 0; j < 8; ++j) a8[j] = 0.f;
                const f16* up = U + (size_t)(t - s) * DP + ch * 8;
                for (int s2 = lo; s2 < hi; ++s2) { const f16x8 v = *(const f16x8*)(up + (size_t)s2 * DP);
#pragma unroll
                    for (int j = 0; j < 8; ++j) a8[j] += (float)v[j]; }
                const f16x8 self = *(const f16x8*)(up + (size_t)s * DP); const float rc = 1.0f / (float)(hi - lo);
                u32x4 o; o.x = pk_f16(a8[0] * rc - (float)self[0], a8[1] * rc - (float)self[1]); o.y = pk_f16(a8[2] * rc - (float)self[2], a8[3] * rc - (float)self[3]);
                o.z = pk_f16(a8[4] * rc - (float)self[4], a8[5] * rc - (float)self[5]); o.w = pk_f16(a8[6] * rc - (float)self[6], a8[7] * rc - (float)self[7]);
                *(u32x4*)(PD + (size_t)t * DP + ch * 8) = o;
            }
            __syncthreads();
        } else {
            f16* VAL = (f16*)(ws + B_VAL); const f16* GATE = (const f16*)(ws + B_GATE);
            const float* cw = args.in[15] + (size_t)layer * 3 * DFF; const float* cb = args.in[16] + (size_t)layer * DFF;
            constexpr int NCH = DFF / 8, TS = 16, NSEG = M / TS;
            for (int it = gt; it < NSEG * NCH; it += NGT) {
                const int seg = it / NCH, fc = it - seg * NCH, f0 = fc * 8, t0 = seg * TS, s0 = t0 & (SEQ - 1);
                f32x2 w0[4], w1[4], w2[4], bb[4];
#pragma unroll
                for (int j = 0; j < 4; ++j) { w0[j] = *(const f32x2*)(cw + f0 + 2 * j); w1[j] = *(const f32x2*)(cw + DFF + f0 + 2 * j); w2[j] = *(const f32x2*)(cw + 2 * DFF + f0 + 2 * j); bb[j] = *(const f32x2*)(cb + f0 + 2 * j); }
                const f16* gp = GATE + (size_t)t0 * DFF + f0; f16* vp = VAL + (size_t)t0 * DFF + f0;
                f16x8 gprev, gcur = *(const f16x8*)gp;
#pragma unroll
                for (int j = 0; j < 8; ++j) gprev[j] = (f16)0.f;
                if (s0 > 0) gprev = *(const f16x8*)(gp - DFF);
#pragma unroll 4
                for (int j = 0; j < TS; ++j) {
                    f16x8 gnext;
#pragma unroll
                    for (int q = 0; q < 8; ++q) gnext[q] = (f16)0.f;
                    if (s0 + j < SEQ - 1) gnext = *(const f16x8*)(gp + (size_t)(j + 1) * DFF);
                    const f16x8 vv = *(const f16x8*)(vp + (size_t)j * DFF);
                    unsigned ow[4];
#pragma unroll
                    for (int q = 0; q < 4; ++q) {
                        const f32x2 a = {(float)gprev[2 * q], (float)gprev[2 * q + 1]}, b = {(float)gcur[2 * q], (float)gcur[2 * q + 1]}, c = {(float)gnext[2 * q], (float)gnext[2 * q + 1]};
                        const f32x2 y = a * w0[q] + b * w1[q] + c * w2[q] + bb[q];
                        const f32x2 g = gelu_pk(y);
                        ow[q] = pk_f16(g.x * (float)vv[2 * q], g.y * (float)vv[2 * q + 1]);
                    }
                    u32x4 o; o.x = ow[0]; o.y = ow[1]; o.z = ow[2]; o.w = ow[3];
                    *(u32x4*)(vp + (size_t)j * DFF) = o;
                    gprev = gcur; gcur = gnext;
                }
            }
        }
        if (step + 1 < NSTEPS) GRID_BAR();
    }
}

extern "C" void kernel_launch(void* const* d_in, const int* in_sizes, int n_in, void* d_out, int out_size, void* d_ws, size_t ws_size, hipStream_t stream) {
    static int grid = 0;
    if (grid == 0) {
        if (n_in != 22 || out_size != M * DM || ws_size < WS_END) { fprintf(stderr, "kernel_launch: unexpected problem (n_in %d, out %d, ws %zu)\n", n_in, out_size, ws_size); grid = -1; return; }
        { const int exp_sizes[22] = {M * DM, DEPTH * M * PLE, DM, DM, DEPTH * DM * NPROJ, DEPTH * NPROJ, DEPTH * NH * 15 * 31, DEPTH * DA * DM, DEPTH * 4 * 128 * 128, DEPTH * DP, DEPTH * DP * DM, DEPTH * DM * DM,
              DEPTH * DM, DEPTH * DM, DEPTH * DM * 2 * DFF, DEPTH * 3 * DFF, DEPTH * DFF, DEPTH * DFF * DM, DEPTH * DM * DM, DEPTH * PLE * DM, DEPTH * DM, DEPTH * DM};
          for (int i = 0; i < 22; ++i) if (in_sizes[i] != exp_sizes[i]) { fprintf(stderr, "kernel_launch: input %d has %d elements, expected %d\n", i, in_sizes[i], exp_sizes[i]); grid = -1; return; } }
        int dev = 0, cus = 0;
        if (hipGetDevice(&dev) != hipSuccess || hipDeviceGetAttribute(&cus, hipDeviceAttributeMultiprocessorCount, dev) != hipSuccess) { grid = -1; return; }
        if (hipFuncSetAttribute((const void*)mk_fwd, hipFuncAttributeMaxDynamicSharedMemorySize, LDS_BYTES) != hipSuccess) { fprintf(stderr, "kernel_launch: hipFuncSetAttribute failed\n"); grid = -1; return; }
        int per_cu = 0;
        if (hipOccupancyMaxActiveBlocksPerMultiprocessor(&per_cu, (const void*)mk_fwd, NTHREADS, LDS_BYTES) != hipSuccess || per_cu < 1) fprintf(stderr, "kernel_launch: occupancy query reports %d\n", per_cu);
        (void)hipGetLastError();
        grid = cus;
    }
    if (grid < 0) return;
    if (hipMemsetAsync((char*)d_ws + WS_CTL, 0, CTL_ZERO_BYTES, stream) != hipSuccess) return;
    Args a{};
    for (int i = 0; i < 22; ++i) a.in[i] = (const float*)d_in[i];
    a.out = (float*)d_out; a.ws = (unsigned char*)d_ws;
    hipLaunchKernelGGL(mk_fwd, dim3(grid), dim3(NTHREADS), LDS_BYTES, stream, a);
}
```
